# Optimizing an MI355X kernel written in HIP

```python
import numpy as np
import jax, jax.numpy as jnp
from jax import lax

D_MODEL = 1024
BATCH = 32
SEQ = 2048
DEPTH = 1

GLA_HEADS = 4
GLA_DV = D_MODEL // 2 // GLA_HEADS
GLA_DK = GLA_DV // 2
GLA_LOWRANK = 16
GLA_TAU = 16.0
GLA_CHUNK = 64
NSA_HEADS = 8
NSA_KV_GROUPS = 2
NSA_HPG = NSA_HEADS // NSA_KV_GROUPS
NSA_DH = D_MODEL // 2 // NSA_HEADS
CMP_LEN = 32
CMP_STRIDE = 16
CMP_HIDDEN = 256
SEL_LEN = 64
SEL_TOPK = 16
WINDOW = 512
SEL_Q_CHUNK = 16
WIN_Q_BLOCK = 128
ROPE_THETA = 10000.0
N_EXPERTS = 256
TOP_K = 8
N_GROUPS = 8
TOPK_GROUPS = 4
D_EXPERT = 256
ROUTED_SCALE = 2.5
MOE_BLOCK = 256
DN_ALPHA = (2.0 * DEPTH) ** 0.25
DN_BETA = (8.0 * DEPTH) ** -0.25
LN_EPS = 1e-5

SPLITS = (
    GLA_HEADS * GLA_DK, GLA_HEADS * GLA_DK, GLA_HEADS * GLA_DV, GLA_LOWRANK, GLA_HEADS * GLA_DV,
    NSA_HEADS * NSA_DH,
    NSA_KV_GROUPS * NSA_DH, NSA_KV_GROUPS * NSA_DH,
    NSA_KV_GROUPS * NSA_DH, NSA_KV_GROUPS * NSA_DH,
    NSA_KV_GROUPS * NSA_DH, NSA_KV_GROUPS * NSA_DH,
    NSA_HEADS * 3,
)
D_IN = sum(SPLITS)

kernel_name = 'hybrid_gla_nsa_moe_deepnorm'


def layer_norm(x, g, b):
    xf = x.astype(jnp.float32)
    mu = jnp.mean(xf, axis=-1, keepdims=True)
    var = jnp.mean(jnp.square(xf - mu), axis=-1, keepdims=True)
    return ((xf - mu) * lax.rsqrt(var + LN_EPS) * g + b).astype(x.dtype)


def rope(x, positions):
    half = x.shape[-1] // 2
    inv = ROPE_THETA ** (-jnp.arange(half, dtype=jnp.float32) / half)
    ang = positions.astype(jnp.float32)[..., None] * inv
    ang = ang.reshape((ang.shape[0],) + (1,) * (x.ndim - 3) + ang.shape[1:])
    cos, sin = jnp.cos(ang), jnp.sin(ang)
    x1 = x[..., :half].astype(jnp.float32)
    x2 = x[..., half:].astype(jnp.float32)
    return jnp.concatenate([x1 * cos - x2 * sin, x2 * cos + x1 * sin], axis=-1).astype(x.dtype)


def masked_softmax(s, mask):
    p = jax.nn.softmax(jnp.where(mask, s.astype(jnp.float32), -1e30), axis=-1)
    return p * mask


def gla_mixer(q, k, v, a_lr, r, w_alpha2, b_alpha, norm_g):
    B, S, _ = q.shape
    H, C = GLA_HEADS, GLA_CHUNK
    nch = S // C
    f32 = jnp.float32

    def heads(t, d):
        return t.astype(f32).reshape(B, nch, C, H, d).transpose(1, 0, 3, 2, 4)

    qh = heads(q, GLA_DK) * GLA_DK ** -0.5
    kh = heads(k, GLA_DK)
    vh = heads(v, GLA_DV)
    log_a = jax.nn.log_sigmoid((a_lr @ w_alpha2 + b_alpha).astype(f32)) / GLA_TAU
    gh = heads(log_a, GLA_DK)
    causal = jnp.tril(jnp.ones((C, C), bool))

    def step(state, inp):
        qc, kc, vc, gc = inp
        b = jnp.cumsum(gc, axis=-2)
        o_inter = jnp.einsum('bhcd,bhde->bhce', qc * jnp.exp(b), state)
        diff = b[:, :, :, None, :] - b[:, :, None, :, :]
        decay = jnp.exp(jnp.where(causal[:, :, None], diff, -jnp.inf))
        att = jnp.einsum('bhid,bhjd,bhijd->bhij', qc, kc, decay)
        o = o_inter + jnp.einsum('bhij,bhje->bhie', att, vc)
        b_last = b[:, :, -1:, :]
        state = state * jnp.exp(b_last)[:, :, 0, :, None] + jnp.einsum(
            'bhcd,bhce->bhde', kc * jnp.exp(b_last - b), vc)
        return state, o

    state0 = jnp.zeros((B, H, GLA_DK, GLA_DV), f32)
    _, o = lax.scan(step, state0, (qh, kh, vh, gh))
    o = o.transpose(1, 0, 3, 2, 4).reshape(B, S, H, GLA_DV)
    o = o * lax.rsqrt(jnp.mean(o * o, axis=-1, keepdims=True) + 1e-6) * norm_g
    o = o.reshape(B, S, H * GLA_DV) * jax.nn.silu(r.astype(f32))
    return o.astype(q.dtype)


def nsa_mixer(q, k_c, v_c, k_s, v_s, k_w, v_w, gates, positions,
              cmp_pos_k, cmp_w1_k, cmp_b1_k, cmp_w2_k,
              cmp_pos_v, cmp_w1_v, cmp_b1_v, cmp_w2_v):
    B, S, _ = q.shape
    G, HPG, DH = NSA_KV_GROUPS, NSA_HPG, NSA_DH
    scale = DH ** -0.5
    tpos = jnp.arange(S)
    qh = rope(q.reshape(B, S, G, HPG, DH).transpose(0, 2, 3, 1, 4), positions)

    def kv(t):
        return t.reshape(B, S, G, DH).transpose(0, 2, 1, 3)

    n_cmp = (S - CMP_LEN) // CMP_STRIDE + 1
    blk_idx = jnp.arange(n_cmp)[:, None] * CMP_STRIDE + jnp.arange(CMP_LEN)[None, :]

    def compress(t, pos_emb, w1, b1, w2):
        blocks = t[:, :, blk_idx] + pos_emb
        hid = jax.nn.gelu(blocks.reshape(B, G, n_cmp, CMP_LEN * DH) @ w1 + b1)
        return hid @ w2

    kc = compress(rope(kv(k_c), positions), cmp_pos_k, cmp_w1_k, cmp_b1_k, cmp_w2_k)
    vc = compress(kv(v_c), cmp_pos_v, cmp_w1_v, cmp_b1_v, cmp_w2_v)
    s_cmp = jnp.einsum('bghsd,bgnd->bghsn', qh, kc) * scale
    cmp_mask = (jnp.arange(n_cmp) * CMP_STRIDE + CMP_LEN - 1)[None, :] <= tpos[:, None]
    p_cmp = masked_softmax(s_cmp, cmp_mask)
    o_cmp = jnp.einsum('bghsn,bgnd->bghsd', p_cmp.astype(vc.dtype), vc)

    n_sel = S // SEL_LEN
    n_top = min(SEL_TOPK, n_sel)
    ci = np.arange(n_cmp)[:, None] * CMP_STRIDE
    sj = np.arange(n_sel)[None, :] * SEL_LEN
    ov = np.clip(np.minimum(ci + CMP_LEN, sj + SEL_LEN) - np.maximum(ci, sj), 0, None) / CMP_LEN
    overlap = jnp.asarray(ov, jnp.float32)
    imp = jnp.einsum('bghsn,nj->bgsj', p_cmp, overlap)
    blk = jnp.arange(n_sel)[None, :]
    cur = (tpos // SEL_LEN)[:, None]
    causal_blk = blk <= cur
    forced = (blk == 0) | (blk == cur) | (blk == cur - 1)
    imp = jnp.where(causal_blk, jnp.where(forced, jnp.inf, imp), -jnp.inf)
    _, sel_idx = lax.top_k(imp, n_top)

    ks = rope(kv(k_s), positions).reshape(B, G, n_sel, SEL_LEN, DH)
    vs = kv(v_s).reshape(B, G, n_sel, SEL_LEN, DH)
    ncq = S // SEL_Q_CHUNK
    q_chunks = qh.reshape(B, G, HPG, ncq, SEL_Q_CHUNK, DH).transpose(3, 0, 1, 2, 4, 5)
    idx_chunks = sel_idx.reshape(B, G, ncq, SEL_Q_CHUNK, n_top).transpose(2, 0, 1, 3, 4)
    t_chunks = tpos.reshape(ncq, SEL_Q_CHUNK)
    bi = jnp.arange(B)[:, None, None, None]
    gi = jnp.arange(G)[None, :, None, None]

    def sel_chunk(inp):
        qc, idx, tc = inp
        kg = ks[bi, gi, idx]
        vg = vs[bi, gi, idx]
        s = jnp.einsum('bghcd,bgcnkd->bghcnk', qc, kg) * scale
        kpos = idx[..., None] * SEL_LEN + jnp.arange(SEL_LEN)
        mask = (kpos <= tc[:, None, None])[:, :, None]
        C = qc.shape[3]
        p = masked_softmax(s.reshape(B, G, HPG, C, n_top * SEL_LEN),
                           mask.reshape(B, G, 1, C, n_top * SEL_LEN))
        p = p.reshape(s.shape).astype(vg.dtype)
        return jnp.einsum('bghcnk,bgcnkd->bghcd', p, vg)

    o_sel = lax.map(sel_chunk, (q_chunks, idx_chunks, t_chunks))
    o_sel = o_sel.transpose(1, 2, 3, 0, 4, 5).reshape(B, G, HPG, S, DH)

    kw = jnp.pad(rope(kv(k_w), positions), ((0, 0), (0, 0), (WINDOW, 0), (0, 0)))
    vw = jnp.pad(kv(v_w), ((0, 0), (0, 0), (WINDOW, 0), (0, 0)))
    nqb = S // WIN_Q_BLOCK
    span = WIN_Q_BLOCK + WINDOW
    q_blocks = qh.reshape(B, G, HPG, nqb, WIN_Q_BLOCK, DH).transpose(3, 0, 1, 2, 4, 5)

    def win_block(inp):
        qb, i = inp
        start = i * WIN_Q_BLOCK
        kb = lax.dynamic_slice_in_dim(kw, start, span, axis=2)
        vb = lax.dynamic_slice_in_dim(vw, start, span, axis=2)
        s = jnp.einsum('bghcd,bgkd->bghck', qb, kb) * scale
        tq = start + jnp.arange(WIN_Q_BLOCK)
        kp = start - WINDOW + jnp.arange(span)
        mask = (kp[None, :] <= tq[:, None]) & (kp[None, :] > tq[:, None] - WINDOW) & (kp[None, :] >= 0)
        p = masked_softmax(s, mask).astype(vb.dtype)
        return jnp.einsum('bghck,bgkd->bghcd', p, vb)

    o_win = lax.map(win_block, (q_blocks, jnp.arange(nqb)))
    o_win = o_win.transpose(1, 2, 3, 0, 4, 5).reshape(B, G, HPG, S, DH)

    g = jax.nn.sigmoid(gates.astype(jnp.float32)).reshape(B, S, G, HPG, 3).transpose(0, 2, 3, 1, 4)
    o = g[..., 0:1] * o_cmp + g[..., 1:2] * o_sel + g[..., 2:3] * o_win
    return o.transpose(0, 3, 1, 2, 4).reshape(B, S, NSA_HEADS * DH).astype(q.dtype)


def moe(h, w_router, router_bias, w_gate, w_up, w_down, ws_gate, ws_up, ws_down):
    B, S, D = h.shape
    T = B * S
    f32 = jnp.float32
    xt = h.reshape(T, D)
    scores = jax.nn.sigmoid((xt @ w_router).astype(f32))
    biased = scores + router_bias
    grp = biased.reshape(T, N_GROUPS, N_EXPERTS // N_GROUPS)
    grp_score = lax.top_k(grp, 2)[0].sum(-1)
    _, gidx = lax.top_k(grp_score, TOPK_GROUPS)
    gmask = jnp.any(gidx[:, :, None] == jnp.arange(N_GROUPS), axis=1)
    emask = jnp.repeat(gmask, N_EXPERTS // N_GROUPS, axis=1)
    _, eidx = lax.top_k(jnp.where(emask, biased, -jnp.inf), TOP_K)
    wts = jnp.take_along_axis(scores, eidx, axis=1)
    wts = wts / jnp.sum(wts, axis=-1, keepdims=True) * ROUTED_SCALE

    P = T * TOP_K
    e_flat = eidx.reshape(P)
    tok_flat = jnp.arange(P, dtype=jnp.int32) // TOP_K
    order = jnp.argsort(e_flat, stable=True)
    e_sorted = e_flat[order]
    counts = jnp.zeros((N_EXPERTS,), jnp.int32).at[e_flat].add(1)
    padded = (counts + MOE_BLOCK - 1) // MOE_BLOCK * MOE_BLOCK
    pad_end = jnp.cumsum(padded)
    pad_start = pad_end - padded
    start = jnp.cumsum(counts) - counts
    dest = pad_start[e_sorted] + jnp.arange(P, dtype=jnp.int32) - start[e_sorted]
    n_blocks = -(-P // MOE_BLOCK) + N_EXPERTS
    buf_tok = jnp.zeros((n_blocks * MOE_BLOCK,), jnp.int32).at[dest].set(tok_flat[order])
    buf_w = jnp.zeros((n_blocks * MOE_BLOCK,), f32).at[dest].set(wts.reshape(P)[order])
    blk_exp = jnp.minimum(jnp.searchsorted(pad_end, jnp.arange(n_blocks, dtype=jnp.int32) * MOE_BLOCK,
                                           side='right'), N_EXPERTS - 1)

    def step(out, inp):
        tok, w, e = inp
        xb = xt[tok]
        y = (jax.nn.silu(xb @ w_gate[e]) * (xb @ w_up[e])) @ w_down[e]
        return out.at[tok].add((y * w[:, None]).astype(out.dtype)), None

    routed, _ = lax.scan(step, jnp.zeros_like(xt),
                         (buf_tok.reshape(n_blocks, MOE_BLOCK), buf_w.reshape(n_blocks, MOE_BLOCK), blk_exp))
    shared = (jax.nn.silu(xt @ ws_gate) * (xt @ ws_up)) @ ws_down
    return (routed + shared).reshape(B, S, D)


def setup_inputs(seed: int = 0) -> dict:
    key = jax.random.key(seed)
    ks = jax.random.split(key, 32)
    f32 = jnp.float32
    L = DEPTH

    def nrm(k, shape, scale):
        return jax.random.normal(k, shape, f32) * scale

    x = jax.random.normal(ks[0], (BATCH, SEQ, D_MODEL), f32)
    positions = (jax.random.randint(ks[1], (BATCH, 1), 0, 1024, dtype=jnp.int32)
                 + jnp.arange(SEQ, dtype=jnp.int32)[None, :])
    return {
        'x': x,
        'positions': positions,
        'w_in': nrm(ks[2], (L, D_MODEL, D_IN), D_MODEL ** -0.5),
        'w_alpha2': nrm(ks[3], (L, GLA_LOWRANK, GLA_HEADS * GLA_DK), GLA_LOWRANK ** -0.5),
        'b_alpha': nrm(ks[4], (L, GLA_HEADS * GLA_DK), 0.5),
        'gla_norm_g': 1.0 + nrm(ks[5], (L, GLA_DV), 0.02),
        'cmp_pos_k': nrm(ks[6], (L, CMP_LEN, NSA_DH), 0.1),
        'cmp_w1_k': nrm(ks[7], (L, CMP_LEN * NSA_DH, CMP_HIDDEN), (CMP_LEN * NSA_DH) ** -0.5),
        'cmp_b1_k': nrm(ks[8], (L, CMP_HIDDEN), 0.02),
        'cmp_w2_k': nrm(ks[9], (L, CMP_HIDDEN, NSA_DH), CMP_HIDDEN ** -0.5),
        'cmp_pos_v': nrm(ks[10], (L, CMP_LEN, NSA_DH), 0.1),
        'cmp_w1_v': nrm(ks[11], (L, CMP_LEN * NSA_DH, CMP_HIDDEN), (CMP_LEN * NSA_DH) ** -0.5),
        'cmp_b1_v': nrm(ks[12], (L, CMP_HIDDEN), 0.02),
        'cmp_w2_v': nrm(ks[13], (L, CMP_HIDDEN, NSA_DH), CMP_HIDDEN ** -0.5),
        'w_out': nrm(ks[14], (L, D_MODEL, D_MODEL), D_MODEL ** -0.5 * DN_BETA),
        'ln1_g': 1.0 + nrm(ks[15], (L, D_MODEL), 0.02),
        'ln1_b': nrm(ks[16], (L, D_MODEL), 0.02),
        'w_router': nrm(ks[17], (L, D_MODEL, N_EXPERTS), D_MODEL ** -0.5),
        'router_bias': nrm(ks[18], (L, N_EXPERTS), 0.01),
        'w_exp_gate': nrm(ks[19], (L, N_EXPERTS, D_MODEL, D_EXPERT), D_MODEL ** -0.5),
        'w_exp_up': nrm(ks[20], (L, N_EXPERTS, D_MODEL, D_EXPERT), D_MODEL ** -0.5),
        'w_exp_down': nrm(ks[21], (L, N_EXPERTS, D_EXPERT, D_MODEL), D_EXPERT ** -0.5 * DN_BETA),
        'w_sh_gate': nrm(ks[22], (L, D_MODEL, D_EXPERT), D_MODEL ** -0.5),
        'w_sh_up': nrm(ks[23], (L, D_MODEL, D_EXPERT), D_MODEL ** -0.5),
        'w_sh_down': nrm(ks[24], (L, D_EXPERT, D_MODEL), D_EXPERT ** -0.5 * DN_BETA),
        'ln2_g': 1.0 + nrm(ks[25], (L, D_MODEL), 0.02),
        'ln2_b': nrm(ks[26], (L, D_MODEL), 0.02),
    }


def reference(x, positions, w_in, w_alpha2, b_alpha, gla_norm_g,
              cmp_pos_k, cmp_w1_k, cmp_b1_k, cmp_w2_k,
              cmp_pos_v, cmp_w1_v, cmp_b1_v, cmp_w2_v,
              w_out, ln1_g, ln1_b, w_router, router_bias,
              w_exp_gate, w_exp_up, w_exp_down, w_sh_gate, w_sh_up, w_sh_down,
              ln2_g, ln2_b):
    split_at = np.cumsum(SPLITS)[:-1].tolist()
    h = x
    for l in range(DEPTH):
        proj = h @ w_in[l]
        (gq, gk, gv, ga, gr, nq, nkc, nvc, nks, nvs, nkw, nvw, ng) = jnp.split(proj, split_at, axis=-1)
        o_gla = gla_mixer(gq, gk, gv, ga, gr, w_alpha2[l], b_alpha[l], gla_norm_g[l])
        o_nsa = nsa_mixer(nq, nkc, nvc, nks, nvs, nkw, nvw, ng, positions,
                          cmp_pos_k[l], cmp_w1_k[l], cmp_b1_k[l], cmp_w2_k[l],
                          cmp_pos_v[l], cmp_w1_v[l], cmp_b1_v[l], cmp_w2_v[l])
        mix = jnp.concatenate([o_gla, o_nsa], axis=-1) @ w_out[l]
        h = layer_norm(DN_ALPHA * h + mix, ln1_g[l], ln1_b[l])
        ffn = moe(h, w_router[l], router_bias[l], w_exp_gate[l], w_exp_up[l], w_exp_down[l],
                  w_sh_gate[l], w_sh_up[l], w_sh_down[l])
        h = layer_norm(DN_ALPHA * h + ffn, ln2_g[l], ln2_b[l])
    return h
```

```cpp
#include <hip/hip_runtime.h>
#include <cstdint>
#include <cstdio>
#include <cmath>

#define LAS __attribute__((address_space(3)))
#define GAS __attribute__((address_space(1)))
typedef unsigned short bf16_t;
typedef short bf16x8 __attribute__((ext_vector_type(8)));
typedef short s16x4 __attribute__((ext_vector_type(4)));
typedef float f32x2 __attribute__((ext_vector_type(2)));
typedef float f32x4 __attribute__((ext_vector_type(4)));
typedef float f32x16 __attribute__((ext_vector_type(16)));
typedef unsigned u32x2 __attribute__((ext_vector_type(2)));
typedef unsigned u32x4 __attribute__((ext_vector_type(4)));

constexpr int NB = 32, SEQ = 2048, DM = 1024, NT = NB * SEQ;
constexpr int NPROJ = 3072;
constexpr int D_IN = 2856;
constexpr int PC_GQ = 0, PC_GK = 256, PC_GV = 512, PC_GR = 1024, PC_NQ = 1536, PC_NKC = 2048, PC_NKS = 2176, PC_NKW = 2304,
              PC_NVC = 2432, PC_NVS = 2560, PC_NVW = 2688, PC_GA = 2816, PC_NG = 2832;
constexpr int OC_GQ = 0, OC_GK = 256, OC_GV = 512, OC_GA = 1024, OC_GR = 1040, OC_NQ = 1552, OC_NKC = 2064, OC_NVC = 2192,
              OC_NKS = 2320, OC_NVS = 2448, OC_NKW = 2576, OC_NVW = 2704, OC_NG = 2832;
constexpr int NEXP = 256, TOPK = 8, DEXP = 256, NPAIR = NT * TOPK;
constexpr int NSEG = 2 * NEXP;
constexpr int HALF_T = NT / 2;
constexpr float DN_ALPHA = 1.189207115002721f;
constexpr float LN_EPS = 1e-5f;
constexpr float LOG2E = 1.4426950408889634f;

constexpr size_t MiB = 1u << 20;
constexpr size_t WS_CTL = 0, CTL_ZERO_BYTES = 1 * MiB;
constexpr size_t WS_BIASKV = 1 * MiB;
constexpr size_t WS_COS = 2 * MiB, WS_SIN = 10 * MiB;
constexpr size_t WS_WIN_T = 18 * MiB;
constexpr size_t WS_WO_T = 24 * MiB;
constexpr size_t WS_WR_T = 26 * MiB;
constexpr size_t WS_WSGU_T = 26 * MiB + 512 * 1024;
constexpr size_t WS_WSD_T = 27 * MiB + 512 * 1024;
constexpr size_t WS_W1K_T = 28 * MiB;
constexpr size_t WS_W1V_T = 29 * MiB;
constexpr size_t WS_KC = 30 * MiB, WS_VC = 31 * MiB;
constexpr size_t WS_EIDX = 32 * MiB;
constexpr size_t WS_WTS = 34 * MiB;
constexpr size_t WS_RANK = 36 * MiB;
constexpr size_t WS_YROW = 38 * MiB;
constexpr size_t WS_EBL = 41 * MiB;
constexpr size_t WS_PROJ = 48 * MiB;
constexpr size_t WS_LOGITS = 48 * MiB;
constexpr size_t WS_ACT = 48 * MiB;
constexpr size_t WS_WD_T = 306 * MiB;
constexpr size_t WS_WGU_T = 434 * MiB;
constexpr size_t WS_Y = 434 * MiB;
constexpr size_t WS_QB = 690 * MiB, WS_KB = 722 * MiB, WS_KL = 754 * MiB;
constexpr size_t WS_H1B = 690 * MiB;
constexpr size_t WS_XB = 818 * MiB;
constexpr size_t WS_MIX = 818 * MiB;
constexpr size_t WS_ACTS = 946 * MiB;
constexpr size_t WS_END = 978 * MiB;
static_assert(WS_PROJ + (size_t)NT * NPROJ * 2 <= WS_WGU_T, "proj");
static_assert(WS_ACT + (size_t)(NPAIR + 256) * 256 * 2 <= WS_WD_T, "act");

constexpr int CW_FLAG = 0;
constexpr int CW_BAR = 4096;
constexpr int CW_CNT = 16384;
constexpr int CW_QHEAD = 20480;

__device__ __forceinline__ unsigned f2bf(float f) { unsigned u = __builtin_bit_cast(unsigned, f); return (u + 0x7fffu + ((u >> 16) & 1u)) >> 16; }
__device__ __forceinline__ unsigned pk2(float lo, float hi) { return f2bf(lo) | (f2bf(hi) << 16); }
__device__ __forceinline__ float bf2f(unsigned short b) { return __builtin_bit_cast(float, (unsigned)b << 16); }
__device__ __forceinline__ float bflo(unsigned w) { return __builtin_bit_cast(float, w << 16); }
__device__ __forceinline__ float bfhi(unsigned w) { return __builtin_bit_cast(float, w & 0xffff0000u); }
__device__ __forceinline__ float wave_sum(float v) {
#pragma unroll
    for (int o = 1; o < 64; o <<= 1) v += __shfl_xor(v, o);
    return v;
}
__device__ __forceinline__ float sigmoidf_(float x) { return 1.0f / (1.0f + __expf(-x)); }
__device__ __forceinline__ float siluf_(float x) { return x / (1.0f + __expf(-x)); }
#define LDS_WAIT() asm volatile("s_waitcnt lgkmcnt(0)" ::: "memory")
#define VM_WAIT() asm volatile("s_waitcnt vmcnt(0)" ::: "memory")
#define XB_TMO      128
#define XB_XCNT(j)  (256  + 64 * (j))
#define XB_XSUB(j)  (1280 + 64 * (j))
#define XB_XGEN(j)  (2304 + 64 * (j))
#define XB_TOP      3328
#define XB_TOPGEN   3392
#define XCD_BAR_WORDS 3456
#define XB_SPIN_CAP (1u << 18)
__device__ __forceinline__ unsigned xb_ld(unsigned* p)              { return __hip_atomic_load(p, __ATOMIC_RELAXED, __HIP_MEMORY_SCOPE_AGENT); }
__device__ __forceinline__ unsigned xb_add(unsigned* p, unsigned v) { return __hip_atomic_fetch_add(p, v, __ATOMIC_RELAXED, __HIP_MEMORY_SCOPE_AGENT); }
__device__ __forceinline__ unsigned xb_xcc_id() { return (unsigned)__builtin_amdgcn_s_getreg((3 << 11) | 20) & 0xFu; }
#define XB_SPIN(cond, bar) do { unsigned _sp = 0; while (cond) { __builtin_amdgcn_s_sleep(1); \
    if ((++_sp & 255u) == 0u) { if (xb_ld(&(bar)[XB_TMO])) break; if (_sp > XB_SPIN_CAP) { atomicAdd(&(bar)[XB_TMO], 1u); break; } } } } while (0)
struct XcdBarrier { unsigned* bar; unsigned x; volatile LAS unsigned* st; };
__device__ __forceinline__ XcdBarrier xcd_barrier_post(unsigned* bar, volatile LAS unsigned* st) {
    XcdBarrier b; b.bar = bar; b.x = xb_xcc_id(); b.st = st;
    if (threadIdx.x == 0) (void)xb_add(&bar[XB_XCNT(b.x)], 1u);
    return b;
}
__device__ __forceinline__ void xcd_barrier_complete(unsigned* bar, unsigned x, unsigned& nloc, unsigned& nx) {
    const unsigned G = gridDim.x * gridDim.y * gridDim.z;
    unsigned sum, cnt, mine, sp = 0u;
    for (;;) {
        sum = 0u; cnt = 0u; mine = 0u;
#pragma unroll
        for (unsigned j = 0; j < 16; ++j) { const unsigned c = xb_ld(&bar[XB_XCNT(j)]); sum += c; cnt += (c > 0u) ? 1u : 0u; mine = (j == x) ? c : mine; }
        if (sum == G) break;
        __builtin_amdgcn_s_sleep(1);
        if ((++sp & 255u) == 0u) { if (xb_ld(&bar[XB_TMO])) break; if (sp > XB_SPIN_CAP) { atomicAdd(&bar[XB_TMO], 1u); break; } }
    }
    nloc = mine > 0u ? mine : 1u; nx = cnt > 0u ? cnt : 1u;
}
__device__ __forceinline__ void xcd_barrier(const XcdBarrier& b) {
    asm volatile("s_waitcnt vmcnt(0)" ::: "memory");
    __syncthreads();
    if (threadIdx.x == 0) {
        unsigned* bar = b.bar;
        __builtin_amdgcn_s_waitcnt(0);
        unsigned nloc = b.st[0], nx = b.st[1];
        if (nloc == 0u) { xcd_barrier_complete(bar, b.x, nloc, nx); b.st[0] = nloc; b.st[1] = nx; }
        const unsigned old = xb_add(&bar[XB_XSUB(b.x)], 1u);
        const unsigned gen = old / nloc;
        if (old + 1u == (gen + 1u) * nloc) {
            __builtin_amdgcn_fence(__ATOMIC_RELEASE, "agent");
            asm volatile("s_waitcnt vmcnt(0)" ::: "memory");
            const unsigned og = xb_add(&bar[XB_TOP], 1u);
            const unsigned tg = og / nx;
            if (og + 1u == (tg + 1u) * nx) xb_add(&bar[XB_TOPGEN], 1u);
            else XB_SPIN(xb_ld(&bar[XB_TOPGEN]) == tg, bar);
            __builtin_amdgcn_fence(__ATOMIC_ACQUIRE, "agent");
            xb_add(&bar[XB_XGEN(b.x)], 1u);
            asm volatile("s_waitcnt vmcnt(0)" ::: "memory");
        } else {
            XB_SPIN(xb_ld(&bar[XB_XGEN(b.x)]) == gen, bar);
            __builtin_amdgcn_fence(__ATOMIC_ACQUIRE, "agent");
            asm volatile("s_waitcnt vmcnt(0)" ::: "memory");
        }
    }
    __syncthreads();
}
namespace pg8 {
constexpr int BM = 256, BK = 64, HALF = 128, HTB = HALF * BK * 2, STAGE_BYTES = 8 * HTB;
__host__ __device__ __forceinline__ int lds_byte(int r, int c) { const int st = (r >> 4) * 2 + (c >> 5), rr = r & 15, cc = c & 31, ob = rr * 64 + cc * 2; return st * 1024 + (ob ^ (((ob >> 9) & 1) << 5)); }
__host__ __device__ __forceinline__ void stage_rc(int b, int& R, int& C) { const int st = b / 1024, sb = b % 1024, swz = sb ^ (((sb >> 9) & 1) << 5); R = (st >> 1) * 16 + swz / 64; C = (st & 1) * 32 + (swz % 64) / 2; }
__host__ __device__ __forceinline__ int perm32(int rho) { const int n = rho >> 4, i = rho & 15; return 8 * (i >> 2) + 4 * n + (i & 3); }
struct Unit { int pm, pn, a0, a1; };
template <class Epi, class Sched, bool ALIGN_EPI>
__device__ __forceinline__ void gemm_phase(LAS unsigned char* lds, const Sched& S, const Epi& E, const int K) {
    int tid_ = threadIdx.x; asm volatile("" : "+v"(tid_));
    const int tid = tid_, wid = __builtin_amdgcn_readfirstlane(tid >> 6), lane = tid & 63, wr = wid >> 2, wc = wid & 3, fr = lane & 15, fq = lane >> 4;
    const int nt = K / BK;
    unsigned voffB[2];
#pragma unroll
    for (int i = 0; i < 2; ++i) { int R, C; stage_rc(tid * 16 + i * 8192, R, C); const int Rb = Epi::PERM ? ((R & ~31) + perm32(R & 31)) : R;
        voffB[i] = (unsigned)(Rb * K + C) * 2u; }
#define PG8_AOFF(dst, unit) do { int t2_ = tid; asm volatile("" : "+v"(t2_)); _Pragma("unroll") for (int i_ = 0; i_ < 2; ++i_) { int R_, C_; stage_rc(t2_ * 16 + i_ * 8192, R_, C_); \
        dst[0][i_] = S.a_off(unit, R_, C_); dst[1][i_] = S.a_off(unit, HALF + R_, C_); } } while (0)
    const size_t kstepB = (size_t)(BK * 2), hstepB = (size_t)HALF * K * 2, kstepA = S.a_kstep();
    const unsigned ldsw = (unsigned)wid * 1024u;
    const int aoff = lds_byte(wr * 64 + fr, fq * 8), boff = lds_byte(wc * 32 + fr, fq * 8);
#define PG8_SA(b, h) (((b) * 2 + (h)) * HTB)
#define PG8_SB(b, h) ((4 + (b) * 2 + (h)) * HTB)
#define PG8_STAGE(bufoff, gbase, voff) do { _Pragma("unroll") for (int _i = 0; _i < 2; ++_i) \
        __builtin_amdgcn_global_load_lds((const unsigned*)((const char*)(gbase) + (voff)[_i]), (LAS unsigned*)(lds + (bufoff) + ldsw + _i * 8192), 16, 0, 0); } while (0)
#define PG8_LDA(dst, b, h) do { _Pragma("unroll") for (int m = 0; m < 4; ++m) _Pragma("unroll") for (int k = 0; k < 2; ++k) dst[m][k] = *(const LAS bf16x8*)(lds + PG8_SA(b, h) + aoff + m * 2048 + k * 1024); } while (0)
#define PG8_LDB(dst, b, h) do { _Pragma("unroll") for (int n = 0; n < 2; ++n) _Pragma("unroll") for (int k = 0; k < 2; ++k) dst[n][k] = *(const LAS bf16x8*)(lds + PG8_SB(b, h) + boff + n * 2048 + k * 1024); } while (0)
#define PG8_MMA(ai, bj, At, Bt) do { __builtin_amdgcn_s_setprio(1); _Pragma("unroll") for (int m = 0; m < 4; ++m) _Pragma("unroll") for (int n = 0; n < 2; ++n) _Pragma("unroll") for (int k = 0; k < 2; ++k) \
        acc[ai][bj][m][n] = __builtin_amdgcn_mfma_f32_16x16x32_bf16(Bt[n][k], At[m][k], acc[ai][bj][m][n], 0, 0, 0); __builtin_amdgcn_s_setprio(0); } while (0)
#define PG8_WAIT_V(n) asm volatile("s_waitcnt vmcnt(" #n ")" ::: "memory")
#define PG8_WAIT_L(n) asm volatile("s_waitcnt lgkmcnt(" #n ")" ::: "memory")
#define PG8_BAR __builtin_amdgcn_s_barrier()
#define PG8_SCHED __builtin_amdgcn_sched_barrier(0)
    Unit cur, nxt; int ui = 0;
    if (!S.next(0, cur)) return;
    f32x4 acc[2][2][4][2];
#pragma unroll
    for (int a = 0; a < 2; ++a)
#pragma unroll
        for (int b = 0; b < 2; ++b)
#pragma unroll
            for (int m = 0; m < 4; ++m)
#pragma unroll
                for (int n = 0; n < 2; ++n) acc[a][b][m][n] = (f32x4){0.f, 0.f, 0.f, 0.f};
    bf16x8 At[4][2], B0[2][2], B1[2][2];
    unsigned vC[2][2], vN[2][2];
    PG8_AOFF(vC, cur);
    const char* cA = S.a_base(cur); const char* cB = S.b_base(cur);
    PG8_STAGE(PG8_SB(0, 0), cB, voffB); PG8_STAGE(PG8_SB(0, 1), cB + hstepB, voffB); PG8_STAGE(PG8_SA(0, 0), cA, vC[0]); PG8_STAGE(PG8_SA(0, 1), cA, vC[1]);
    if (wr == 1) PG8_BAR;
    PG8_WAIT_V(2); PG8_BAR;
    PG8_STAGE(PG8_SB(1, 0), cB + kstepB, voffB); PG8_STAGE(PG8_SA(1, 0), cA + kstepA, vC[0]); PG8_STAGE(PG8_SB(1, 1), cB + hstepB + kstepB, voffB);
    PG8_WAIT_V(6); PG8_BAR;
    for (;;) {
        const bool has_next = S.next(ui + 1, nxt);
        const char* nA = has_next ? S.a_base(nxt) : cA; const char* nB = has_next ? S.b_base(nxt) : cB;
        if (has_next) { PG8_AOFF(vN, nxt); } else {
#pragma unroll
            for (int h = 0; h < 2; ++h)
#pragma unroll
                for (int i = 0; i < 2; ++i) vN[h][i] = vC[h][i]; }
#pragma nounroll
        for (int t = 0; t < nt; t += 2) {
            const bool last = (t == nt - 2);
            const char* a1 = cA + (size_t)(t + 1) * kstepA;
            const char* a2 = last ? nA : cA + (size_t)(t + 2) * kstepA; const char* b2 = last ? nB : cB + (size_t)(t + 2) * kstepB;
            const char* a3 = a2 + kstepA; const char* b3 = b2 + kstepB;
            unsigned v2[2][2];
#pragma unroll
            for (int h = 0; h < 2; ++h)
#pragma unroll
                for (int i = 0; i < 2; ++i) v2[h][i] = last ? vN[h][i] : vC[h][i];
            PG8_LDB(B0, 0, 0); PG8_LDB(B1, 0, 1); PG8_SCHED; PG8_LDA(At, 0, 0); PG8_STAGE(PG8_SA(1, 1), a1, vC[1]);
            PG8_WAIT_V(8); PG8_WAIT_L(0); PG8_BAR; PG8_MMA(0, 0, At, B0); PG8_MMA(0, 1, At, B1); PG8_BAR; PG8_SCHED;
            PG8_LDA(At, 0, 1); PG8_STAGE(PG8_SB(0, 0), b2, voffB); PG8_STAGE(PG8_SB(0, 1), b2 + hstepB, voffB); PG8_STAGE(PG8_SA(0, 0), a2, v2[0]);
            PG8_WAIT_V(8); PG8_WAIT_L(0); PG8_BAR; PG8_MMA(1, 0, At, B0); PG8_MMA(1, 1, At, B1); PG8_BAR; PG8_SCHED;
            PG8_LDB(B0, 1, 0); PG8_LDB(B1, 1, 1); PG8_SCHED; PG8_LDA(At, 1, 0); PG8_STAGE(PG8_SA(0, 1), a2, v2[1]);
            PG8_WAIT_V(8); PG8_WAIT_L(0); PG8_BAR; PG8_MMA(0, 0, At, B0); PG8_MMA(0, 1, At, B1); PG8_BAR; PG8_SCHED;
            PG8_LDA(At, 1, 1); PG8_STAGE(PG8_SB(1, 0), b3, voffB); PG8_STAGE(PG8_SB(1, 1), b3 + hstepB, voffB); PG8_STAGE(PG8_SA(1, 0), a3, v2[0]);
            PG8_WAIT_V(8); PG8_WAIT_L(0); PG8_BAR; PG8_MMA(1, 0, At, B0); PG8_MMA(1, 1, At, B1); PG8_BAR; PG8_SCHED;
        }
        if constexpr (ALIGN_EPI) { if (wr == 0) PG8_BAR; }
        if constexpr (!Epi::AFTER_DRAIN) { E(acc, cur, wr, wc, fr, fq); }
        if (!has_next) break;
#pragma unroll
        for (int a = 0; a < 2; ++a)
#pragma unroll
            for (int b = 0; b < 2; ++b)
#pragma unroll
                for (int m = 0; m < 4; ++m)
#pragma unroll
                    for (int n = 0; n < 2; ++n) acc[a][b][m][n] = (f32x4){0.f, 0.f, 0.f, 0.f};
        cur = nxt; cA = nA; cB = nB; ++ui;
#pragma unroll
        for (int h = 0; h < 2; ++h)
#pragma unroll
            for (int i = 0; i < 2; ++i) vC[h][i] = vN[h][i];
        if constexpr (ALIGN_EPI) { if (wr == 1) PG8_BAR; }
    }
    PG8_WAIT_V(0);
    if constexpr (!ALIGN_EPI) { if (wr == 0) PG8_BAR; }
    PG8_BAR;
    if constexpr (Epi::AFTER_DRAIN) { E.fused(acc, cur, wr, wc, fr, fq, lds, wid, lane); }
#undef PG8_AOFF
#undef PG8_SA
#undef PG8_SB
#undef PG8_STAGE
#undef PG8_LDA
#undef PG8_LDB
#undef PG8_MMA
#undef PG8_WAIT_V
#undef PG8_WAIT_L
#undef PG8_BAR
#undef PG8_SCHED
}
}
struct Params {
    const float* x; const int* positions; const float* w_in; const float* w_alpha2; const float* b_alpha; const float* gla_norm_g;
    const float* cmp_pos_k; const float* cmp_w1_k; const float* cmp_b1_k; const float* cmp_w2_k;
    const float* cmp_pos_v; const float* cmp_w1_v; const float* cmp_b1_v; const float* cmp_w2_v;
    const float* w_out; const float* ln1_g; const float* ln1_b; const float* w_router; const float* router_bias;
    const float* w_exp_gate; const float* w_exp_up; const float* w_exp_down; const float* w_sh_gate; const float* w_sh_up; const float* w_sh_down;
    const float* ln2_g; const float* ln2_b;
    float* out; unsigned char* ws;
};
struct Ctx { int tid, lane, wave, vb, nvb; LAS unsigned char* lds; };

__device__ __forceinline__ int rope_od(int cc) { return (cc >> 1) + 32 * (cc & 1); }
__device__ __forceinline__ int proj_src(int pc, float& sc) {
    sc = 1.f;
    if (pc < 256) { sc = 0.125f; return OC_GQ + pc; }
    if (pc < 512) return OC_GK + (pc - 256);
    if (pc < 1024) return OC_GV + (pc - 512);
    if (pc < 1536) return OC_GR + (pc - 1024);
    if (pc < 2048) { const int c = pc - 1536; sc = 0.125f * LOG2E; return OC_NQ + (c & ~63) + rope_od(c & 63); }
    if (pc < 2176) { const int c = pc - 2048; return OC_NKC + (c & ~63) + rope_od(c & 63); }
    if (pc < 2304) { const int c = pc - 2176; return OC_NKS + (c & ~63) + rope_od(c & 63); }
    if (pc < 2432) { const int c = pc - 2304; return OC_NKW + (c & ~63) + rope_od(c & 63); }
    if (pc < 2560) return OC_NVC + (pc - 2432);
    if (pc < 2688) return OC_NVS + (pc - 2560);
    if (pc < 2816) return OC_NVW + (pc - 2688);
    if (pc < 2832) return OC_GA + (pc - 2816);
    if (pc < 2856) return OC_NG + (pc - 2832);
    return -1;
}
struct SrcWin { const float* W; __device__ __forceinline__ float operator()(int k, int n) const { float sc; const int oc = proj_src(n, sc); return oc < 0 ? 0.f : W[(size_t)k * D_IN + oc] * sc; } };
struct SrcPlain { const float* W; int ld; __device__ __forceinline__ float operator()(int k, int n) const { return W[(size_t)k * ld + n]; } };
struct SrcGU { const float* G; const float* U; __device__ __forceinline__ float operator()(int k, int n) const { return (n & 1) ? U[(size_t)k * DEXP + (n >> 1)] : G[(size_t)k * DEXP + (n >> 1)]; } };
struct SrcW1K { const float* W; __device__ __forceinline__ float operator()(int k, int n) const { const int kr = (k & ~63) + rope_od(k & 63); return W[(size_t)kr * 256 + n]; } };
template <class Src> __device__ __forceinline__ void tr_item(const Src& src, bf16_t* WT, int ldt, int k0, int n0, LAS float* scr, int lane) {
#pragma unroll 8
    for (int i = 0; i < 32; ++i) { const int kk = 2 * i + (lane >> 5); scr[kk * 33 + (lane & 31)] = src(k0 + kk, n0 + (lane & 31)); }
    LDS_WAIT(); asm volatile("" ::: "memory");
    const int c = lane & 7;
#pragma unroll
    for (int j = 0; j < 4; ++j) { const int n = (lane >> 3) + 8 * j; const LAS float* s = scr + (8 * c) * 33 + n;
        u32x4 o; o.x = pk2(s[0 * 33], s[1 * 33]); o.y = pk2(s[2 * 33], s[3 * 33]); o.z = pk2(s[4 * 33], s[5 * 33]); o.w = pk2(s[6 * 33], s[7 * 33]);
        *(u32x4*)(WT + (size_t)(n0 + n) * ldt + k0 + 8 * c) = o; }
    LDS_WAIT(); asm volatile("" ::: "memory");
}
template <class Src> __device__ __forceinline__ void tr_matrix(const Src& src, bf16_t* WT, int K, int N, LAS float* scr, int lane, int gw, int NGW, int& cursor) {
    const int nblk = N / 32, nit = (K / 64) * nblk;
    int first = (gw - cursor % NGW + NGW) % NGW;
    for (int it = first; it < nit; it += NGW) tr_item(src, WT, K, 64 * (it / nblk), 32 * (it % nblk), scr, lane);
    cursor += nit;
}

__device__ __forceinline__ void ph_prologue(const Params& p, const Ctx& c) {
    LAS float* scr = (LAS float*)(c.lds + c.wave * 8704);
    const int gw = c.vb * 8 + c.wave, NGW = c.nvb * 8;
    unsigned char* ws = p.ws;
    int cur = 0;
    tr_matrix(SrcWin{p.w_in}, (bf16_t*)(ws + WS_WIN_T), DM, NPROJ, scr, c.lane, gw, NGW, cur);
    tr_matrix(SrcPlain{p.w_out, DM}, (bf16_t*)(ws + WS_WO_T), DM, DM, scr, c.lane, gw, NGW, cur);
    tr_matrix(SrcPlain{p.w_router, NEXP}, (bf16_t*)(ws + WS_WR_T), DM, NEXP, scr, c.lane, gw, NGW, cur);
    tr_matrix(SrcGU{p.w_sh_gate, p.w_sh_up}, (bf16_t*)(ws + WS_WSGU_T), DM, 2 * DEXP, scr, c.lane, gw, NGW, cur);
    tr_matrix(SrcPlain{p.w_sh_down, DM}, (bf16_t*)(ws + WS_WSD_T), DEXP, DM, scr, c.lane, gw, NGW, cur);
    tr_matrix(SrcW1K{p.cmp_w1_k}, (bf16_t*)(ws + WS_W1K_T), 2048, 256, scr, c.lane, gw, NGW, cur);
    tr_matrix(SrcPlain{p.cmp_w1_v, 256}, (bf16_t*)(ws + WS_W1V_T), 2048, 256, scr, c.lane, gw, NGW, cur);
    const size_t gt = (size_t)c.vb * 512 + c.tid, NGT = (size_t)c.nvb * 512;
    { const f32x4* xs = (const f32x4*)p.x; u32x4* xd = (u32x4*)(ws + WS_XB);
      for (size_t i = gt; i < (size_t)NT * DM / 8; i += NGT) { const f32x4 a = xs[2 * i], b = xs[2 * i + 1]; u32x4 o; o.x = pk2(a.x, a.y); o.y = pk2(a.z, a.w); o.z = pk2(b.x, b.y); o.w = pk2(b.z, b.w); xd[i] = o; } }
    { float* cs = (float*)(ws + WS_COS); float* sn = (float*)(ws + WS_SIN);
      for (size_t i = gt; i < (size_t)NT * 32; i += NGT) { const int t = (int)(i >> 5), f = (int)(i & 31);
        const float inv = powf(10000.0f, -(float)f / 32.0f); const float ang = (float)p.positions[t] * inv; float s, co; sincosf(ang, &s, &co); cs[i] = co; sn[i] = s; } }
    if (gt < 512) { const int which = (int)(gt >> 8), j = (int)(gt & 255); const float* pos = which ? p.cmp_pos_v : p.cmp_pos_k; const float* w1 = which ? p.cmp_w1_v : p.cmp_w1_k;
        float a = (which ? p.cmp_b1_v : p.cmp_b1_k)[j];
        for (int m = 0; m < 2048; ++m) a += pos[m] * w1[(size_t)m * 256 + j];
        ((float*)(ws + WS_BIASKV))[gt] = a; }
}
__device__ __forceinline__ void conv_wgu(const Params& p, const Ctx& c, int first_wave, int nwaves_total, int it_end) {
    LAS float* scr = (LAS float*)(c.lds + c.wave * 8704);
    constexpr int PER = (DM / 64) * (2 * DEXP / 32);
    for (int it = first_wave; it < it_end; it += nwaves_total) { const int e = it / PER, r = it % PER;
        tr_item(SrcGU{p.w_exp_gate + (size_t)e * DM * DEXP, p.w_exp_up + (size_t)e * DM * DEXP}, (bf16_t*)(p.ws + WS_WGU_T) + (size_t)e * 2 * DEXP * DM, DM, 64 * (r / 16), 32 * (r % 16), scr, c.lane); }
}
__device__ __forceinline__ void conv_wd(const Params& p, const Ctx& c, int first_wave, int nwaves_total, int it_end) {
    LAS float* scr = (LAS float*)(c.lds + c.wave * 8704);
    constexpr int PER = (DEXP / 64) * (DM / 32);
    for (int it = first_wave; it < it_end; it += nwaves_total) { const int e = it / PER, r = it % PER;
        tr_item(SrcPlain{p.w_exp_down + (size_t)e * DEXP * DM, DM}, (bf16_t*)(p.ws + WS_WD_T) + (size_t)e * DM * DEXP, DEXP, 64 * (r / 32), 32 * (r % 32), scr, c.lane); }
}
struct SchedPlain {
    const char* A; const char* Bt; int lda, K, nM, nN, G, c;
    __device__ __forceinline__ bool next(int i, pg8::Unit& u) const {
        const long L = (long)i * G + c; const int nwg = nM * nN; if (L >= nwg) return false;
        int wgid = (int)L; { const int q = nwg / 8, r = nwg % 8, xcd = wgid % 8, off = wgid / 8; wgid = (xcd < r ? xcd * (q + 1) : r * (q + 1) + (xcd - r) * q) + off; }
        const int nig = 8 * nN, gid = wgid / nig, fm = gid * 8, gsz = (nM - fm) < 8 ? (nM - fm) : 8;
        u.pm = fm + ((wgid % nig) % gsz); u.pn = (wgid % nig) / gsz; u.a0 = 0; u.a1 = 0; return true;
    }
    __device__ __forceinline__ const char* a_base(const pg8::Unit& u) const { return A + (size_t)u.pm * 256 * lda * 2; }
    __device__ __forceinline__ unsigned a_off(const pg8::Unit&, int row, int C) const { return (unsigned)(row * lda + C) * 2u; }
    __device__ __forceinline__ size_t a_kstep() const { return 128; }
    __device__ __forceinline__ const char* b_base(const pg8::Unit& u) const { return Bt + (size_t)u.pn * 256 * K * 2; }
};
struct SchedCmp {
    const char* proj; const char* W1k; const char* W1v; int G, c;
    __device__ __forceinline__ bool next(int i, pg8::Unit& u) const { const int L = i * G + c; if (L >= 64) return false; u.pm = L >> 1; u.a0 = L & 1; u.pn = 0; u.a1 = 0; return true; }
    __device__ __forceinline__ const char* a_base(const pg8::Unit& u) const { return proj + ((size_t)u.pm * SEQ * NPROJ + (u.a0 ? PC_NVC : PC_NKC)) * 2; }
    __device__ __forceinline__ unsigned a_off(const pg8::Unit&, int row, int C) const { return (unsigned)((row & 127) * 16 * NPROJ + (row >> 7) * 64 + C) * 2u; }
    __device__ __forceinline__ size_t a_kstep() const { return (size_t)NPROJ * 2; }
    __device__ __forceinline__ const char* b_base(const pg8::Unit& u) const { return u.a0 ? W1v : W1k; }
};

struct EpiProj {
    static constexpr bool PERM = true, AFTER_DRAIN = false;
    bf16_t* O; const float* cs; const float* sn;
    __device__ __forceinline__ void operator()(const f32x4 (&acc)[2][2][4][2], const pg8::Unit& u, int wr, int wc, int fr, int fq) const {
        const int row0 = u.pm * 256 + wr * 64 + fr, pn = u.pn;
#pragma unroll
        for (int ai = 0; ai < 2; ++ai)
#pragma unroll
            for (int m = 0; m < 4; ++m) { const int row = row0 + ai * 128 + m * 16;
#pragma unroll
                for (int bj = 0; bj < 2; ++bj) { const int col0 = pn * 256 + bj * 128 + wc * 32 + 8 * fq;
                    f32x4 v0 = acc[ai][bj][m][0], v1 = acc[ai][bj][m][1];
                    const bool rope = (pn >= 6 && pn <= 8) || (pn == 9 && bj == 0);
                    if (rope) { const int i0 = (col0 & 63) >> 1; const f32x4 c4 = *(const f32x4*)(cs + (size_t)row * 32 + i0), s4 = *(const f32x4*)(sn + (size_t)row * 32 + i0);
                        v0 = (f32x4){v0[0] * c4[0] - v0[1] * s4[0], v0[1] * c4[0] + v0[0] * s4[0], v0[2] * c4[1] - v0[3] * s4[1], v0[3] * c4[1] + v0[2] * s4[1]};
                        v1 = (f32x4){v1[0] * c4[2] - v1[1] * s4[2], v1[1] * c4[2] + v1[0] * s4[2], v1[2] * c4[3] - v1[3] * s4[3], v1[3] * c4[3] + v1[2] * s4[3]}; }
                    u32x4 w; w.x = pk2(v0[0], v0[1]); w.y = pk2(v0[2], v0[3]); w.z = pk2(v1[0], v1[1]); w.w = pk2(v1[2], v1[3]);
                    *(u32x4*)(O + (size_t)row * NPROJ + col0) = w; } }
    }
};
struct EpiAxpyF32 {
    static constexpr bool PERM = false, AFTER_DRAIN = false;
    const float* base; float* out; int ldc; float alpha;
    __device__ __forceinline__ void operator()(const f32x4 (&acc)[2][2][4][2], const pg8::Unit& u, int wr, int wc, int fr, int fq) const {
        const int row0 = u.pm * 256 + wr * 64 + fr;
#pragma unroll
        for (int ai = 0; ai < 2; ++ai)
#pragma unroll
            for (int m = 0; m < 4; ++m) { const size_t ro = (size_t)(row0 + ai * 128 + m * 16) * ldc;
#pragma unroll
                for (int bj = 0; bj < 2; ++bj)
#pragma unroll
                    for (int n = 0; n < 2; ++n) { const int col = u.pn * 256 + bj * 128 + wc * 32 + n * 16 + 4 * fq;
                        f32x4 o = acc[ai][bj][m][n]; if (base) { const f32x4 b = *(const f32x4*)(base + ro + col); o = b * alpha + o; }
                        *(f32x4*)(out + ro + col) = o; } }
    }
};
__device__ __forceinline__ float gelu_tanh(float x) { const float u = 0.7978845608028654f * (x + 0.044715f * x * x * x); const float e = __expf(2.f * u); const float t = 1.f - 2.f / (e + 1.f); return 0.5f * x * (1.f + t); }
struct EpiCmp {
    static constexpr bool PERM = false, AFTER_DRAIN = true;
    const float* biaskv; const float* w2k; const float* w2v; bf16_t* kc; bf16_t* vc;
    __device__ __forceinline__ void fused(f32x4 (&acc)[2][2][4][2], const pg8::Unit& u, int wr, int wc, int fr, int fq, LAS unsigned char* lds, int wid, int lane) const {
        LAS bf16_t* hT = (LAS bf16_t*)lds;
        const int which = u.a0; const float* bias = biaskv + which * 256;
#pragma unroll
        for (int bj = 0; bj < 2; ++bj)
#pragma unroll
            for (int n = 0; n < 2; ++n) { const int col = bj * 128 + wc * 32 + n * 16 + 4 * fq; const f32x4 bv = *(const f32x4*)(bias + col);
#pragma unroll
                for (int ai = 0; ai < 2; ++ai)
#pragma unroll
                    for (int m = 0; m < 4; ++m) { const int row = ai * 128 + wr * 64 + m * 16 + fr; const f32x4 v = acc[ai][bj][m][n] + bv;
#pragma unroll
                        for (int e = 0; e < 4; ++e) hT[(col + e) * 256 + row] = (bf16_t)f2bf(gelu_tanh(v[e])); } }
        LDS_WAIT(); __syncthreads();
        const int row = threadIdx.x & 255, ch = __builtin_amdgcn_readfirstlane(threadIdx.x >> 8);
        const float* w2 = (which ? w2v : w2k) + ch * 32;
        float o[32];
#pragma unroll
        for (int j = 0; j < 32; ++j) o[j] = 0.f;
        for (int k = 0; k < 256; ++k) { const float h = bf2f(hT[k * 256 + row]);
#pragma unroll
            for (int j = 0; j < 32; ++j) o[j] += h * w2[k * 64 + j]; }
        const int g = row >> 7, n = row & 127; bf16_t* dst = (which ? vc : kc) + ((size_t)(u.pm * 2 + g) * 128 + n) * 64;
        if (n == 127) {
#pragma unroll
            for (int j = 0; j < 32; ++j) o[j] = 0.f; }
        if (which) {
#pragma unroll
            for (int j = 0; j < 32; j += 2) *(unsigned*)(dst + ch * 32 + j) = pk2(o[j], o[j + 1]);
        } else {
#pragma unroll
            for (int j = 0; j < 32; ++j) dst[2 * j + ch] = (bf16_t)f2bf(o[j]); }
        __syncthreads();
    }
};
typedef short v4i16_t __attribute__((ext_vector_type(4)));
__device__ __forceinline__ s16x4 tr_rd(const LAS unsigned char* p) { return __builtin_bit_cast(s16x4, __builtin_amdgcn_ds_read_tr16_b64_v4i16((LAS v4i16_t*)p)); }
__device__ __forceinline__ bf16x8 cat8(s16x4 lo, s16x4 hi) { return (bf16x8){lo[0], lo[1], lo[2], lo[3], hi[0], hi[1], hi[2], hi[3]}; }
#define MFMA32(a, b, c) __builtin_amdgcn_mfma_f32_32x32x16_bf16((a), (b), (c), 0, 0, 0)
__device__ __forceinline__ bf16x8 ld16(const LAS unsigned char* p) { return *(const LAS bf16x8*)p; }

__device__ __forceinline__ void gla_prep_unit(const Params& p, const Ctx& c, int unit) {
    LAS float* ga = (LAS float*)c.lds; LAS float* tot = ga + 1024;
    const bf16_t* proj = (const bf16_t*)(p.ws + WS_PROJ);
    const size_t row0 = (size_t)unit * 64;
    for (int i = c.tid; i < 1024; i += 512) ga[i] = bf2f(proj[(row0 + (i >> 4)) * NPROJ + PC_GA + (i & 15)]);
    const int col = c.tid & 255, half = c.tid >> 8;
    float w[16];
#pragma unroll
    for (int k = 0; k < 16; ++k) w[k] = p.w_alpha2[k * 256 + col];
    const float bal = p.b_alpha[col];
    __syncthreads();
    float bl[32]; float csum = 0.f;
#pragma unroll
    for (int r = 0; r < 32; ++r) { const LAS float* g = ga + (half * 32 + r) * 16; float z = bal;
#pragma unroll
        for (int k = 0; k < 16; ++k) z += g[k] * w[k];
        const float ls = fminf(z, 0.f) - log1pf(__expf(-fabsf(z)));
        csum += ls * (1.0f / 16.0f); bl[r] = csum; }
    if (half == 0) tot[col] = csum;
    __syncthreads();
    const float off = half ? tot[col] : 0.f;
    __syncthreads();
    if (half == 1) tot[col] = csum + off;
    __syncthreads();
    const float blast = tot[col];
    bf16_t* QB = (bf16_t*)(p.ws + WS_QB); bf16_t* KB = (bf16_t*)(p.ws + WS_KB); bf16_t* KL = (bf16_t*)(p.ws + WS_KL);
#pragma unroll 4
    for (int r = 0; r < 32; ++r) { const float b = bl[r] + off; const size_t row = row0 + half * 32 + r;
        const float q = bf2f(proj[row * NPROJ + PC_GQ + col]), k = bf2f(proj[row * NPROJ + PC_GK + col]);
        QB[row * 256 + col] = (bf16_t)f2bf(q * __expf(b)); KB[row * 256 + col] = (bf16_t)f2bf(k * __expf(-b)); KL[row * 256 + col] = (bf16_t)f2bf(k * __expf(blast - b)); }
    if (half == 0) ((float*)(p.ws + WS_EBL))[(size_t)unit * 256 + col] = __expf(blast);
    __syncthreads();
}

constexpr int GL_QB = 0, GL_KB = 9216, GL_KL = 18432, GL_V = 26624, GL_ATT = 43008, GL_ST = 52224, GL_O = 70656, GL_EB = 104448, GL_END = 104704;
__device__ __forceinline__ void gla_unit(const Params& p, const Ctx& c, int unit) {
    const int b = unit >> 2, hd = unit & 3;
    LAS unsigned char* L = c.lds;
    const int tid = c.tid, lane = c.lane, w = c.wave, r32 = lane & 31, h = lane >> 5, gi = (lane >> 4) & 1, li = lane & 15;
    const bf16_t* QB = (const bf16_t*)(p.ws + WS_QB); const bf16_t* KB = (const bf16_t*)(p.ws + WS_KB); const bf16_t* KL = (const bf16_t*)(p.ws + WS_KL);
    const bf16_t* proj = (const bf16_t*)(p.ws + WS_PROJ); const float* EBL = (const float*)(p.ws + WS_EBL);
    bf16_t* MIX = (bf16_t*)(p.ws + WS_MIX);
    const int ci = w >> 2, ei = w & 3;
    const int lr = tid >> 3, lch = tid & 7;
    u32x4 pq, pk, pl, pv0, pv1; float peb = 0.f;
    auto gload = [&](int chunk) {
        const size_t row = (size_t)b * SEQ + chunk * 64;
        pq = *(const u32x4*)(QB + (row + lr) * 256 + hd * 64 + lch * 8);
        pk = *(const u32x4*)(KB + (row + lr) * 256 + hd * 64 + lch * 8);
        pl = *(const u32x4*)(KL + (row + lr) * 256 + hd * 64 + lch * 8);
        { const int i0 = tid, i1 = tid + 512;
          pv0 = *(const u32x4*)(proj + (row + (i0 >> 4)) * NPROJ + PC_GV + hd * 128 + (i0 & 15) * 8);
          pv1 = *(const u32x4*)(proj + (row + (i1 >> 4)) * NPROJ + PC_GV + hd * 128 + (i1 & 15) * 8); }
        if (tid < 64) peb = EBL[((size_t)b * 32 + chunk) * 256 + hd * 64 + tid];
    };
    auto lstore = [&]() {
        *(LAS u32x4*)(L + GL_QB + (lr * 72 + lch * 8) * 2) = pq;
        *(LAS u32x4*)(L + GL_KB + (lr * 72 + lch * 8) * 2) = pk;
        *(LAS u32x4*)(L + GL_KL + (lch >> 2) * 4096 + lr * 64 + (lch & 3) * 16) = pl;
        { const int i0 = tid, i1 = tid + 512;
          *(LAS u32x4*)(L + GL_V + ((i0 & 15) >> 2) * 4096 + (i0 >> 4) * 64 + (i0 & 3) * 16) = pv0;
          *(LAS u32x4*)(L + GL_V + ((i1 & 15) >> 2) * 4096 + (i1 >> 4) * 64 + (i1 & 3) * 16) = pv1; }
        if (tid < 64) ((LAS float*)(L + GL_EB))[tid] = peb;
    };
    f32x16 S = {};
    gload(0); lstore(); LDS_WAIT(); __syncthreads();
    const int trA = (li >> 2) * 64 + (16 * gi + 4 * (li & 3)) * 2;
    for (int chunk = 0; chunk < 32; ++chunk) {
        if (chunk + 1 < 32) gload(chunk + 1);
#pragma unroll
        for (int rq = 0; rq < 4; ++rq) { u32x2 o2; o2.x = pk2(S[4 * rq], S[4 * rq + 1]); o2.y = pk2(S[4 * rq + 2], S[4 * rq + 3]);
            *(LAS u32x2*)(L + GL_ST + ((32 * ei + r32) * 72 + 32 * ci + 8 * rq + 4 * h) * 2) = o2; }
        if (w < 3) { const int aci = (w + 1) >> 1, acj = w >> 1;
            f32x16 a = {};
#pragma unroll
            for (int s = 0; s < 4; ++s) { const bf16x8 ka = ld16(L + GL_KB + ((32 * acj + r32) * 72 + 16 * s + 8 * h) * 2), qa = ld16(L + GL_QB + ((32 * aci + r32) * 72 + 16 * s + 8 * h) * 2);
                a = MFMA32(ka, qa, a); }
#pragma unroll
            for (int rq = 0; rq < 4; ++rq) { float v[4];
#pragma unroll
                for (int e = 0; e < 4; ++e) { const int j = 32 * acj + 8 * rq + 4 * h + e, cg = 32 * aci + r32; v[e] = (j <= cg) ? a[4 * rq + e] : 0.f; }
                u32x2 o2; o2.x = pk2(v[0], v[1]); o2.y = pk2(v[2], v[3]);
                *(LAS u32x2*)(L + GL_ATT + ((32 * aci + r32) * 72 + 32 * acj + 8 * rq + 4 * h) * 2) = o2; } }
        LDS_WAIT(); __syncthreads();
        bf16x8 vf[4];
#pragma unroll
        for (int s = 0; s < 4; ++s) { const LAS unsigned char* a0 = L + GL_V + ei * 4096 + (16 * s + 8 * h) * 64 + trA; vf[s] = cat8(tr_rd(a0), tr_rd(a0 + 256)); }
        f32x16 o = {};
#pragma unroll
        for (int s = 0; s < 4; ++s) { if (ci == 1 || s < 2) { const bf16x8 aa = ld16(L + GL_ATT + ((32 * ci + r32) * 72 + 16 * s + 8 * h) * 2); o = MFMA32(aa, vf[s], o); } }
#pragma unroll
        for (int s = 0; s < 4; ++s) { const bf16x8 qa = ld16(L + GL_QB + ((32 * ci + r32) * 72 + 16 * s + 8 * h) * 2), sb = ld16(L + GL_ST + ((32 * ei + r32) * 72 + 16 * s + 8 * h) * 2); o = MFMA32(qa, sb, o); }
        { LAS float* LO = (LAS float*)(L + GL_O);
#pragma unroll
          for (int r = 0; r < 16; ++r) LO[(32 * ci + (r & 3) + 8 * (r >> 2) + 4 * h) * 132 + 32 * ei + r32] = o[r]; }
#pragma unroll
        for (int rq = 0; rq < 4; ++rq) { const f32x4 e4 = *(const LAS f32x4*)(L + GL_EB + (32 * ci + 8 * rq + 4 * h) * 4);
#pragma unroll
            for (int e = 0; e < 4; ++e) S[4 * rq + e] *= e4[e]; }
#pragma unroll
        for (int s = 0; s < 4; ++s) { const LAS unsigned char* a0 = L + GL_KL + ci * 4096 + (16 * s + 8 * h) * 64 + trA; const bf16x8 ka = cat8(tr_rd(a0), tr_rd(a0 + 256)); S = MFMA32(ka, vf[s], S); }
        LDS_WAIT(); __syncthreads();
        { const int tok = tid >> 3, part = tid & 7; const LAS float* LO = (const LAS float*)(L + GL_O) + tok * 132 + part * 16;
          f32x4 v4[4]; float ss = 0.f;
#pragma unroll
          for (int q = 0; q < 4; ++q) { v4[q] = *(const LAS f32x4*)(LO + 4 * q); ss += v4[q].x * v4[q].x + v4[q].y * v4[q].y + v4[q].z * v4[q].z + v4[q].w * v4[q].w; }
          ss += __shfl_xor(ss, 1); ss += __shfl_xor(ss, 2); ss += __shfl_xor(ss, 4);
          const float rs = rsqrtf(ss * (1.0f / 128.0f) + 1e-6f);
          const size_t row = (size_t)b * SEQ + chunk * 64 + tok;
          const u32x4 r0 = *(const u32x4*)(proj + row * NPROJ + PC_GR + hd * 128 + part * 16), r1 = *(const u32x4*)(proj + row * NPROJ + PC_GR + hd * 128 + part * 16 + 8);
          const unsigned rw[8] = {r0.x, r0.y, r0.z, r0.w, r1.x, r1.y, r1.z, r1.w};
          unsigned ow[8];
#pragma unroll
          for (int q = 0; q < 4; ++q) { const f32x4 g4 = *(const f32x4*)(p.gla_norm_g + part * 16 + 4 * q);
              const float a0 = v4[q].x * rs * g4.x * siluf_(bflo(rw[2 * q])), a1 = v4[q].y * rs * g4.y * siluf_(bfhi(rw[2 * q]));
              const float a2 = v4[q].z * rs * g4.z * siluf_(bflo(rw[2 * q + 1])), a3 = v4[q].w * rs * g4.w * siluf_(bfhi(rw[2 * q + 1]));
              ow[2 * q] = pk2(a0, a1); ow[2 * q + 1] = pk2(a2, a3); }
          *(u32x4*)(MIX + row * DM + hd * 128 + part * 16) = (u32x4){ow[0], ow[1], ow[2], ow[3]};
          *(u32x4*)(MIX + row * DM + hd * 128 + part * 16 + 8) = (u32x4){ow[4], ow[5], ow[6], ow[7]}; }
        if (chunk + 1 < 32) lstore();
        LDS_WAIT(); __syncthreads();
    }
}
constexpr int NS_BUF = 17408, NS_K = 0, NS_V = 9216, NS_IMP = 2 * NS_BUF, NS_SEL = NS_IMP + 32768, NS_END = NS_SEL + 256;
__device__ __forceinline__ void attn_tile(const LAS unsigned char* Kb, const LAS unsigned char* Vb, const bf16x8 (&Qf)[4], int kmin, int kmax, bool nomask,
                                          int r32, int h, int trA, float& m, float& l, f32x16 (&O)[2]) {
    f32x16 p0 = {}, p1 = {};
#pragma unroll
    for (int s = 0; s < 4; ++s) { const bf16x8 a0 = ld16(Kb + (r32 * 72 + 16 * s + 8 * h) * 2), a1 = ld16(Kb + ((32 + r32) * 72 + 16 * s + 8 * h) * 2);
        p0 = MFMA32(a0, Qf[s], p0); p1 = MFMA32(a1, Qf[s], p1); }
    if (!nomask) {
#pragma unroll
        for (int r = 0; r < 16; ++r) { const int ko = (r & 3) + 8 * (r >> 2) + 4 * h;
            p0[r] = (ko >= kmin && ko <= kmax) ? p0[r] : -INFINITY; p1[r] = (ko + 32 >= kmin && ko + 32 <= kmax) ? p1[r] : -INFINITY; } }
    float mx = fmaxf(p0[0], p1[0]);
#pragma unroll
    for (int r = 1; r < 16; ++r) mx = fmaxf(mx, fmaxf(p0[r], p1[r]));
    mx = fmaxf(mx, __shfl_xor(mx, 32));
    const float mnew = fmaxf(m, mx), ms = (mnew == -INFINITY) ? 0.f : mnew;
    const float alpha = __builtin_amdgcn_exp2f(m - ms);
    float rs = 0.f;
#pragma unroll
    for (int r = 0; r < 16; ++r) { p0[r] = __builtin_amdgcn_exp2f(p0[r] - ms); p1[r] = __builtin_amdgcn_exp2f(p1[r] - ms); rs += p0[r] + p1[r]; }
    l = l * alpha + rs; m = mnew;
#pragma unroll
    for (int r = 0; r < 16; ++r) { O[0][r] *= alpha; O[1][r] *= alpha; }
#pragma unroll
    for (int hf = 0; hf < 2; ++hf)
#pragma unroll
        for (int s = 0; s < 2; ++s) {
            u32x4 pw;
            if (hf == 0) { pw.x = pk2(p0[8 * s], p0[8 * s + 1]); pw.y = pk2(p0[8 * s + 2], p0[8 * s + 3]); pw.z = pk2(p0[8 * s + 4], p0[8 * s + 5]); pw.w = pk2(p0[8 * s + 6], p0[8 * s + 7]); }
            else         { pw.x = pk2(p1[8 * s], p1[8 * s + 1]); pw.y = pk2(p1[8 * s + 2], p1[8 * s + 3]); pw.z = pk2(p1[8 * s + 4], p1[8 * s + 5]); pw.w = pk2(p1[8 * s + 6], p1[8 * s + 7]); }
            const bf16x8 pf = __builtin_bit_cast(bf16x8, pw);
#pragma unroll
            for (int dh = 0; dh < 2; ++dh) { const LAS unsigned char* a0 = Vb + dh * 4096 + (32 * hf + 16 * s + 4 * h) * 64 + trA;
                const bf16x8 vf = cat8(tr_rd(a0), tr_rd(a0 + 512)); O[dh] = MFMA32(vf, pf, O[dh]); } }
}

__device__ __forceinline__ void nsa_unit(const Params& p, const Ctx& c, int unit) {
    const int tile = 31 - (unit >> 6), bg = unit & 63, b = bg >> 1, g = bg & 1, cur = tile, t0 = tile * 64;
    LAS unsigned char* L = c.lds;
    const int tid = c.tid, lane = c.lane, w = c.wave, r32 = lane & 31, h = lane >> 5, gi = (lane >> 4) & 1, li = lane & 15;
    const int hh = w >> 1, th = w & 1, hq = g * 4 + hh, qo = 32 * th + r32;
    const int trA = (li >> 2) * 64 + (16 * gi + 4 * (li & 3)) * 2;
    const bf16_t* proj = (const bf16_t*)(p.ws + WS_PROJ);
    const size_t rowb = (size_t)b * SEQ;
    const size_t qrow = rowb + t0 + qo;
    bf16x8 Qf[4];
#pragma unroll
    for (int s = 0; s < 4; ++s) Qf[s] = *(const bf16x8*)(proj + qrow * NPROJ + PC_NQ + hq * 64 + 16 * s + 8 * h);
    float g0, g1, g2;
    { const bf16_t* gp = proj + qrow * NPROJ + PC_NG + hq * 3; g0 = sigmoidf_(bf2f(gp[0])); g1 = sigmoidf_(bf2f(gp[1])); g2 = sigmoidf_(bf2f(gp[2])); }
    const int skey = tid >> 3, sch = tid & 7;
    const int kdst = (skey * 72 + sch * 8) * 2, vdst = (sch >> 2) * 4096 + skey * 64 + (sch & 3) * 16;
    u32x4 pkr, pvr;
    const bool useB = (t0 + 32) >= 1024;
    { const bf16_t* KC = (const bf16_t*)(p.ws + WS_KC) + (size_t)bg * 128 * 64; const bf16_t* VC = (const bf16_t*)(p.ws + WS_VC) + (size_t)bg * 128 * 64;
      pkr = *(const u32x4*)(KC + skey * 64 + sch * 8); pvr = *(const u32x4*)(VC + skey * 64 + sch * 8);
      *(LAS u32x4*)(L + NS_K + kdst) = pkr; *(LAS u32x4*)(L + NS_V + vdst) = pvr;
      if (useB) { pkr = *(const u32x4*)(KC + (64 + skey) * 64 + sch * 8); pvr = *(const u32x4*)(VC + (64 + skey) * 64 + sch * 8);
          *(LAS u32x4*)(L + NS_BUF + NS_K + kdst) = pkr; *(LAS u32x4*)(L + NS_BUF + NS_V + vdst) = pvr; } }
    pkr = *(const u32x4*)(proj + (rowb + 64 * cur + skey) * NPROJ + PC_NKS + g * 64 + sch * 8);
    pvr = *(const u32x4*)(proj + (rowb + 64 * cur + skey) * NPROJ + PC_NVS + g * 64 + sch * 8);
    LDS_WAIT(); __syncthreads();
    f32x16 acc[2]; acc[0] = (f32x16){}; acc[1] = (f32x16){};
    {
        const int t = t0 + qo; const int nmax = (t >= 31) ? ((t - 31) >> 4) : -1;
        f32x16 pa0 = {}, pa1 = {}, pb0 = {}, pb1 = {};
#pragma unroll
        for (int s = 0; s < 4; ++s) { const bf16x8 a0 = ld16(L + NS_K + (r32 * 72 + 16 * s + 8 * h) * 2), a1 = ld16(L + NS_K + ((32 + r32) * 72 + 16 * s + 8 * h) * 2);
            pa0 = MFMA32(a0, Qf[s], pa0); pa1 = MFMA32(a1, Qf[s], pa1); }
        if (useB) {
#pragma unroll
            for (int s = 0; s < 4; ++s) { const bf16x8 a0 = ld16(L + NS_BUF + NS_K + (r32 * 72 + 16 * s + 8 * h) * 2), a1 = ld16(L + NS_BUF + NS_K + ((32 + r32) * 72 + 16 * s + 8 * h) * 2);
                pb0 = MFMA32(a0, Qf[s], pb0); pb1 = MFMA32(a1, Qf[s], pb1); } }
        float mx = -INFINITY;
#pragma unroll
        for (int r = 0; r < 16; ++r) { const int n = (r & 3) + 8 * (r >> 2) + 4 * h;
            pa0[r] = (n <= nmax) ? pa0[r] : -INFINITY; pa1[r] = (n + 32 <= nmax) ? pa1[r] : -INFINITY;
            pb0[r] = (useB && n + 64 <= nmax) ? pb0[r] : -INFINITY; pb1[r] = (useB && n + 96 <= nmax) ? pb1[r] : -INFINITY;
            mx = fmaxf(fmaxf(mx, fmaxf(pa0[r], pa1[r])), fmaxf(pb0[r], pb1[r])); }
        mx = fmaxf(mx, __shfl_xor(mx, 32));
        const float ms = (mx == -INFINITY) ? 0.f : mx;
        float rs = 0.f;
#pragma unroll
        for (int r = 0; r < 16; ++r) { pa0[r] = __builtin_amdgcn_exp2f(pa0[r] - ms); pa1[r] = __builtin_amdgcn_exp2f(pa1[r] - ms); pb0[r] = __builtin_amdgcn_exp2f(pb0[r] - ms); pb1[r] = __builtin_amdgcn_exp2f(pb1[r] - ms);
            rs += (pa0[r] + pa1[r]) + (pb0[r] + pb1[r]); }
        rs += __shfl_xor(rs, 32);
        const float inv = rs > 0.f ? 1.0f / rs : 0.f;
#pragma unroll
        for (int r = 0; r < 16; ++r) { pa0[r] *= inv; pa1[r] *= inv; pb0[r] *= inv; pb1[r] *= inv; }
        { LAS float* IMP = (LAS float*)(L + NS_IMP) + ((size_t)hh * 64 + qo) * 32;
          float A[16], tl[16];
#pragma unroll
          for (int rq = 0; rq < 4; ++rq) {
              A[rq] = pa0[4 * rq] + pa0[4 * rq + 1] + pa0[4 * rq + 2] + 0.5f * pa0[4 * rq + 3]; tl[rq] = 0.5f * pa0[4 * rq + 3];
              A[4 + rq] = pa1[4 * rq] + pa1[4 * rq + 1] + pa1[4 * rq + 2] + 0.5f * pa1[4 * rq + 3]; tl[4 + rq] = 0.5f * pa1[4 * rq + 3];
              A[8 + rq] = pb0[4 * rq] + pb0[4 * rq + 1] + pb0[4 * rq + 2] + 0.5f * pb0[4 * rq + 3]; tl[8 + rq] = 0.5f * pb0[4 * rq + 3];
              A[12 + rq] = pb1[4 * rq] + pb1[4 * rq + 1] + pb1[4 * rq + 2] + 0.5f * pb1[4 * rq + 3]; tl[12 + rq] = 0.5f * pb1[4 * rq + 3]; }
          float prev = 0.f;
#pragma unroll
          for (int i = 0; i < 16; ++i) { const float ot = __shfl_xor(tl[i], 32); IMP[2 * i + h] = A[i] + (h ? ot : prev); prev = ot; } }
        f32x16 O[2]; O[0] = (f32x16){}; O[1] = (f32x16){};
#pragma unroll
        for (int tt = 0; tt < 2; ++tt) { if (tt == 0 || useB) {
#pragma unroll
            for (int hf = 0; hf < 2; ++hf)
#pragma unroll
                for (int s = 0; s < 2; ++s) { const f32x16& P = tt == 0 ? (hf == 0 ? pa0 : pa1) : (hf == 0 ? pb0 : pb1);
                    u32x4 pw; pw.x = pk2(P[8 * s], P[8 * s + 1]); pw.y = pk2(P[8 * s + 2], P[8 * s + 3]); pw.z = pk2(P[8 * s + 4], P[8 * s + 5]); pw.w = pk2(P[8 * s + 6], P[8 * s + 7]);
                    const bf16x8 pf = __builtin_bit_cast(bf16x8, pw);
#pragma unroll
                    for (int dh = 0; dh < 2; ++dh) { const LAS unsigned char* a0 = L + tt * NS_BUF + NS_V + dh * 4096 + (32 * hf + 16 * s + 4 * h) * 64 + trA;
                        O[dh] = MFMA32(cat8(tr_rd(a0), tr_rd(a0 + 512)), pf, O[dh]); } } } }
#pragma unroll
        for (int r = 0; r < 16; ++r) { acc[0][r] = g0 * O[0][r]; acc[1][r] = g0 * O[1][r]; }
    }
    LDS_WAIT(); __syncthreads();
    { const int tok = tid >> 3, sub = tid & 7; const LAS float* I0 = (const LAS float*)(L + NS_IMP) + tok * 32;
      float v[32];
#pragma unroll
      for (int q = 0; q < 8; ++q) { f32x4 s4 = *(const LAS f32x4*)(I0 + 4 * q);
#pragma unroll
          for (int hd = 1; hd < 4; ++hd) s4 += *(const LAS f32x4*)(I0 + hd * 64 * 32 + 4 * q);
          v[4 * q] = s4.x; v[4 * q + 1] = s4.y; v[4 * q + 2] = s4.z; v[4 * q + 3] = s4.w; }
#pragma unroll
      for (int k = 0; k < 32; ++k) v[k] = (k > cur) ? -INFINITY : ((k == 0 || k == cur || k == cur - 1) ? INFINITY : v[k]);
      unsigned bits = 0u;
#pragma unroll
      for (int jj = 0; jj < 4; ++jj) {
          float vj = 0.f;
#pragma unroll
          for (int k = 0; k < 32; ++k) vj = (k == 4 * sub + jj) ? v[k] : vj;
          const int j = 4 * sub + jj; int rank = 0;
#pragma unroll
          for (int k = 0; k < 32; ++k) rank += (v[k] > vj || (v[k] == vj && k < j)) ? 1 : 0;
          if (rank < 16 && j <= cur) bits |= 1u << j; }
      bits |= __shfl_xor(bits, 1); bits |= __shfl_xor(bits, 2); bits |= __shfl_xor(bits, 4);
      if (sub == 0) ((LAS unsigned*)(L + NS_SEL))[tok] = bits; }
    *(LAS u32x4*)(L + NS_K + kdst) = pkr; *(LAS u32x4*)(L + NS_V + vdst) = pvr;
    LDS_WAIT(); __syncthreads();
    const unsigned selmask = ((const LAS unsigned*)(L + NS_SEL))[qo];
    const int nsel = cur + 1, nwin = (cur < 8 ? cur : 8) + 1, ntile = nsel + nwin;
    float m = -INFINITY, l = 0.f; f32x16 O[2]; O[0] = (f32x16){}; O[1] = (f32x16){};
    for (int i = 0; i < ntile; ++i) {
        if (i + 1 < ntile) { const int i1 = i + 1; const bool ws1 = i1 >= nsel; const int j1 = ws1 ? cur - (i1 - nsel) : i1 - 1;
            const int kc_ = ws1 ? PC_NKW : PC_NKS, vc_ = ws1 ? PC_NVW : PC_NVS;
            pkr = *(const u32x4*)(proj + (rowb + 64 * j1 + skey) * NPROJ + kc_ + g * 64 + sch * 8);
            pvr = *(const u32x4*)(proj + (rowb + 64 * j1 + skey) * NPROJ + vc_ + g * 64 + sch * 8); }
        if (i == nsel) {
            const float lt = l + __shfl_xor(l, 32), inv = lt > 0.f ? g1 / lt : 0.f;
#pragma unroll
            for (int r = 0; r < 16; ++r) { acc[0][r] += inv * O[0][r]; acc[1][r] += inv * O[1][r]; O[0][r] = 0.f; O[1][r] = 0.f; }
            m = -INFINITY; l = 0.f; }
        const bool wsel = i >= nsel; const int iw = i - nsel;
        const int j = wsel ? cur - iw : (i == 0 ? cur : i - 1);
        int kmin = 0, kmax = 63; bool nomask = true;
        if (!wsel) { if (i == 0) { kmax = qo; nomask = false; } if (!((selmask >> j) & 1u)) { kmax = -1; } if (!__all((selmask >> j) & 1u)) nomask = false; }
        else { if (iw == 0) { kmax = qo; nomask = false; } else if (iw == 8) { kmin = qo + 1; nomask = false; } }
        const LAS unsigned char* bufp = L + (i & 1) * NS_BUF;
        if (wsel || __any((selmask >> j) & 1u)) attn_tile(bufp + NS_K, bufp + NS_V, Qf, kmin, kmax, nomask, r32, h, trA, m, l, O);
        if (i + 1 < ntile) { LAS unsigned char* nb = L + ((i + 1) & 1) * NS_BUF; *(LAS u32x4*)(nb + NS_K + kdst) = pkr; *(LAS u32x4*)(nb + NS_V + vdst) = pvr; }
        LDS_WAIT(); __syncthreads();
    }
    { const float lt = l + __shfl_xor(l, 32), inv = lt > 0.f ? g2 / lt : 0.f;
#pragma unroll
      for (int r = 0; r < 16; ++r) { acc[0][r] += inv * O[0][r]; acc[1][r] += inv * O[1][r]; } }
    bf16_t* MIX = (bf16_t*)(p.ws + WS_MIX) + qrow * DM + 512 + hq * 64;
#pragma unroll
    for (int dh = 0; dh < 2; ++dh)
#pragma unroll
        for (int rq = 0; rq < 4; ++rq) { u32x2 o2; o2.x = pk2(acc[dh][4 * rq], acc[dh][4 * rq + 1]); o2.y = pk2(acc[dh][4 * rq + 2], acc[dh][4 * rq + 3]);
            *(u32x2*)(MIX + 32 * dh + 8 * rq + 4 * h) = o2; }
}
__device__ __forceinline__ void ln_row(f32x4 (&a)[4], const float* g, const float* bta, int lane) {
    float s = 0.f;
#pragma unroll
    for (int j = 0; j < 4; ++j) s += (a[j].x + a[j].y) + (a[j].z + a[j].w);
    const float mean = wave_sum(s) * (1.0f / DM); float q = 0.f;
#pragma unroll
    for (int j = 0; j < 4; ++j) { a[j] = a[j] - mean; q += (a[j].x * a[j].x + a[j].y * a[j].y) + (a[j].z * a[j].z + a[j].w * a[j].w); }
    const float rstd = rsqrtf(wave_sum(q) * (1.0f / DM) + LN_EPS);
#pragma unroll
    for (int j = 0; j < 4; ++j) { const int col = (j >> 1) * 512 + 8 * lane + (j & 1) * 4; const f32x4 g4 = *(const f32x4*)(g + col), b4 = *(const f32x4*)(bta + col); a[j] = a[j] * rstd * g4 + b4; }
}
__device__ __forceinline__ void ph_ln1(const Params& p, const Ctx& c) {
    const int gw = c.vb * 8 + c.wave, NGW = c.nvb * 8; bf16_t* H1B = (bf16_t*)(p.ws + WS_H1B);
    for (int row = gw; row < NT; row += NGW) { float* xr = p.out + (size_t)row * DM; f32x4 a[4];
#pragma unroll
        for (int j = 0; j < 4; ++j) a[j] = *(const f32x4*)(xr + (j >> 1) * 512 + 8 * c.lane + (j & 1) * 4);
        ln_row(a, p.ln1_g, p.ln1_b, c.lane);
#pragma unroll
        for (int j = 0; j < 4; ++j) *(f32x4*)(xr + (j >> 1) * 512 + 8 * c.lane + (j & 1) * 4) = a[j];
#pragma unroll
        for (int j = 0; j < 2; ++j) { u32x4 o; o.x = pk2(a[2 * j].x, a[2 * j].y); o.y = pk2(a[2 * j].z, a[2 * j].w); o.z = pk2(a[2 * j + 1].x, a[2 * j + 1].y); o.w = pk2(a[2 * j + 1].z, a[2 * j + 1].w);
            *(u32x4*)(H1B + (size_t)row * DM + j * 512 + 8 * c.lane) = o; } }
}
__device__ __forceinline__ void ph_route(const Params& p, const Ctx& c) {
    const int gw = c.vb * 8 + c.wave, NGW = c.nvb * 8, lane = c.lane;
    const float* LG = (const float*)(p.ws + WS_LOGITS); int* EIDX = (int*)(p.ws + WS_EIDX); float* WTS = (float*)(p.ws + WS_WTS); int* RANK = (int*)(p.ws + WS_RANK);
    unsigned* CNT = (unsigned*)(p.ws + WS_CTL) + CW_CNT;
    const f32x4 rb = *(const f32x4*)(p.router_bias + 4 * lane);
    for (int t = gw; t < NT; t += NGW) {
        const f32x4 lg = *(const f32x4*)(LG + (size_t)t * NEXP + 4 * lane);
        float sc[4], bs[4];
#pragma unroll
        for (int i = 0; i < 4; ++i) { sc[i] = 1.0f / (1.0f + expf(-lg[i])); bs[i] = sc[i] + rb[i]; }
        float a1 = fmaxf(bs[0], bs[1]), a2 = fminf(bs[0], bs[1]);
        { const float b1 = fmaxf(bs[2], bs[3]), b2 = fminf(bs[2], bs[3]); const float n1 = fmaxf(a1, b1), n2 = fmaxf(fminf(a1, b1), fmaxf(a2, b2)); a1 = n1; a2 = n2; }
#pragma unroll
        for (int o = 1; o < 8; o <<= 1) { const float b1 = __shfl_xor(a1, o), b2 = __shfl_xor(a2, o); const float n1 = fmaxf(a1, b1), n2 = fmaxf(fminf(a1, b1), fmaxf(a2, b2)); a1 = n1; a2 = n2; }
        const float gs = a1 + a2; const int mygrp = lane >> 3; int grank = 0;
#pragma unroll
        for (int k = 0; k < 8; ++k) { const float o = __shfl(gs, k * 8); grank += (o > gs || (o == gs && k < mygrp)) ? 1 : 0; }
        const bool gsel = grank < 4;
        float val[4];
#pragma unroll
        for (int i = 0; i < 4; ++i) val[i] = gsel ? bs[i] : -INFINITY;
        int my_e = 0; float my_s = 0.f, ssum = 0.f;
#pragma unroll
        for (int k = 0; k < TOPK; ++k) {
            float bv = val[0]; int bi = 4 * lane; float bsx = sc[0];
#pragma unroll
            for (int i = 1; i < 4; ++i) { if (val[i] > bv) { bv = val[i]; bi = 4 * lane + i; bsx = sc[i]; } }
#pragma unroll
            for (int o = 32; o >= 1; o >>= 1) { const float ov = __shfl_xor(bv, o); const int oi = __shfl_xor(bi, o); const float os = __shfl_xor(bsx, o);
                if (ov > bv || (ov == bv && oi < bi)) { bv = ov; bi = oi; bsx = os; } }
#pragma unroll
            for (int i = 0; i < 4; ++i) if (bi == 4 * lane + i) val[i] = -INFINITY;
            ssum += bsx; if (lane == k) { my_e = bi; my_s = bsx; }
        }
        if (lane < TOPK) { const int seg = (t >= HALF_T ? NEXP : 0) + my_e;
            EIDX[(size_t)t * TOPK + lane] = my_e; WTS[(size_t)t * TOPK + lane] = my_s / ssum * 2.5f;
            RANK[(size_t)t * TOPK + lane] = (int)__hip_atomic_fetch_add(CNT + seg, 1u, __ATOMIC_RELAXED, __HIP_MEMORY_SCOPE_AGENT); }
    }
}
constexpr int LDS_MISC = 131072;
constexpr int LM_BARW = LDS_MISC;
constexpr int LM_Q = LDS_MISC + 16;
constexpr int LM_OFFS = LDS_MISC + 64;
constexpr int LM_TB = LM_OFFS + 2064;
constexpr int LM_SCAN = LM_TB + 2064;
constexpr int LDS_BYTES = 147456;
static_assert(LM_SCAN + 4096 <= LDS_BYTES, "lds misc");
__device__ __forceinline__ void build_tables(const Params& p, const Ctx& c) {
    const unsigned* CNT = (const unsigned*)(p.ws + WS_CTL) + CW_CNT;
    LAS unsigned* offs = (LAS unsigned*)(c.lds + LM_OFFS); LAS unsigned* tb = (LAS unsigned*)(c.lds + LM_TB);
    LAS unsigned* s0 = (LAS unsigned*)(c.lds + LM_SCAN); LAS unsigned* s1 = s0 + 512;
    const int t = c.tid; const unsigned cn = __hip_atomic_load(CNT + t, __ATOMIC_RELAXED, __HIP_MEMORY_SCOPE_AGENT);
    s0[t] = cn; s1[t] = (cn + 255u) >> 8;
    __syncthreads();
    if (t == 0) { unsigned a = 0, b = 0; for (int i = 0; i < NSEG; ++i) { offs[i] = a; tb[i] = b; a += s0[i]; b += s1[i]; } offs[NSEG] = a; tb[NSEG] = b; }
    __syncthreads();
}
__device__ __forceinline__ void ph_scatter(const Params& p, const Ctx& c) {
    build_tables(p, c);
    const LAS unsigned* offs = (const LAS unsigned*)(c.lds + LM_OFFS);
    const int* EIDX = (const int*)(p.ws + WS_EIDX); const int* RANK = (const int*)(p.ws + WS_RANK); int* YROW = (int*)(p.ws + WS_YROW);
    const size_t gt = (size_t)c.vb * 512 + c.tid, NGT = (size_t)c.nvb * 512;
    for (size_t i = gt; i < (size_t)NPAIR; i += NGT) { const int t = (int)(i >> 3); const int seg = (t >= HALF_T ? NEXP : 0) + EIDX[i]; YROW[offs[seg] + RANK[i]] = (int)i; }
    if (gt < 256) YROW[NPAIR + gt] = 0;
}
__device__ __forceinline__ int seg_of_tile(const LAS unsigned* tb, unsigned tile) { int lo = 0, hi = NSEG;
    while (hi - lo > 1) { const int mid = (lo + hi) >> 1; if ((unsigned)__builtin_amdgcn_readfirstlane((int)tb[mid]) <= tile) lo = mid; else hi = mid; } return lo; }
struct SchedMoE1 {
    const char* H1B; const char* WGU; const int* yrow; const LAS unsigned* offs; const LAS unsigned* tb; int G, c;
    __device__ __forceinline__ bool next(int i, pg8::Unit& u) const { const unsigned L = (unsigned)i * G + c; const unsigned ntile = (unsigned)__builtin_amdgcn_readfirstlane((int)tb[NSEG]); if (L >= 2 * ntile) return false;
        const unsigned tile = L >> 1; const int s = seg_of_tile(tb, tile); const unsigned row0 = offs[s] + 256u * (tile - tb[s]); const unsigned rem = offs[s + 1] - row0;
        u.pm = __builtin_amdgcn_readfirstlane((int)row0); u.pn = __builtin_amdgcn_readfirstlane((int)(L & 1)); u.a0 = __builtin_amdgcn_readfirstlane(rem < 256u ? (int)rem : 256); u.a1 = __builtin_amdgcn_readfirstlane(s & (NEXP - 1)); return true; }
    __device__ __forceinline__ const char* a_base(const pg8::Unit&) const { return H1B; }
    __device__ __forceinline__ unsigned a_off(const pg8::Unit& u, int row, int C) const { const int r = row < u.a0 ? row : u.a0 - 1; const unsigned tok = (unsigned)yrow[u.pm + r] >> 3; return (tok * DM + C) * 2u; }
    __device__ __forceinline__ size_t a_kstep() const { return 128; }
    __device__ __forceinline__ const char* b_base(const pg8::Unit& u) const { return WGU + ((size_t)u.a1 * 2 * DEXP + (size_t)u.pn * 256) * DM * 2; }
};
struct SchedMoE2 {
    const char* ACT; const char* WD; const LAS unsigned* offs; const LAS unsigned* tb; int half, G, c;
    __device__ __forceinline__ bool next(int i, pg8::Unit& u) const { const unsigned L = (unsigned)i * G + c; const unsigned t0 = (unsigned)__builtin_amdgcn_readfirstlane((int)tb[half * NEXP]), ntile = (unsigned)__builtin_amdgcn_readfirstlane((int)tb[half * NEXP + NEXP]) - t0; if (L >= 4 * ntile) return false;
        const unsigned tile = t0 + (L >> 2); const int s = seg_of_tile(tb, tile); const unsigned row0 = offs[s] + 256u * (tile - tb[s]); const unsigned rem = offs[s + 1] - row0;
        u.pm = __builtin_amdgcn_readfirstlane((int)row0); u.pn = __builtin_amdgcn_readfirstlane((int)(L & 3)); u.a0 = __builtin_amdgcn_readfirstlane(rem < 256u ? (int)rem : 256); u.a1 = __builtin_amdgcn_readfirstlane(s & (NEXP - 1)); return true; }
    __device__ __forceinline__ const char* a_base(const pg8::Unit& u) const { return ACT + (size_t)u.pm * DEXP * 2; }
    __device__ __forceinline__ unsigned a_off(const pg8::Unit&, int row, int C) const { return (unsigned)(row * DEXP + C) * 2u; }
    __device__ __forceinline__ size_t a_kstep() const { return 128; }
    __device__ __forceinline__ const char* b_base(const pg8::Unit& u) const { return WD + ((size_t)u.a1 * DM + (size_t)u.pn * 256) * DEXP * 2; }
};
struct EpiAct {
    static constexpr bool PERM = true, AFTER_DRAIN = false;
    bf16_t* O; bool pos;
    __device__ __forceinline__ void operator()(const f32x4 (&acc)[2][2][4][2], const pg8::Unit& u, int wr, int wc, int fr, int fq) const {
        const size_t rbase = pos ? (size_t)u.pm : (size_t)u.pm * 256; const int nvalid = pos ? u.a0 : 256;
#pragma unroll
        for (int ai = 0; ai < 2; ++ai)
#pragma unroll
            for (int m = 0; m < 4; ++m) { const int r = ai * 128 + wr * 64 + m * 16 + fr;
                if (r < nvalid) {
#pragma unroll
                    for (int bj = 0; bj < 2; ++bj) { const int acol = (u.pn * 256 + bj * 128 + wc * 32 + 8 * fq) >> 1; const f32x4 v0 = acc[ai][bj][m][0], v1 = acc[ai][bj][m][1];
                        u32x2 o; o.x = pk2(siluf_(v0[0]) * v0[1], siluf_(v0[2]) * v0[3]); o.y = pk2(siluf_(v1[0]) * v1[1], siluf_(v1[2]) * v1[3]);
                        *(u32x2*)(O + (rbase + r) * DEXP + acol) = o; } } }
    }
};
struct EpiY {
    static constexpr bool PERM = true, AFTER_DRAIN = false;
    bf16_t* Y; const int* yrow; int half;
    __device__ __forceinline__ void operator()(const f32x4 (&acc)[2][2][4][2], const pg8::Unit& u, int wr, int wc, int fr, int fq) const {
#pragma unroll
        for (int ai = 0; ai < 2; ++ai)
#pragma unroll
            for (int m = 0; m < 4; ++m) { const int r = ai * 128 + wr * 64 + m * 16 + fr;
                if (r < u.a0) { const size_t yr = (size_t)(yrow[u.pm + r] - half * HALF_T * TOPK);
#pragma unroll
                    for (int bj = 0; bj < 2; ++bj) { const int col0 = u.pn * 256 + bj * 128 + wc * 32 + 8 * fq; const f32x4 v0 = acc[ai][bj][m][0], v1 = acc[ai][bj][m][1];
                        u32x4 w; w.x = pk2(v0[0], v0[1]); w.y = pk2(v0[2], v0[3]); w.z = pk2(v1[0], v1[1]); w.w = pk2(v1[2], v1[3]);
                        *(u32x4*)(Y + yr * DM + col0) = w; } } }
    }
};
__device__ __forceinline__ void ph_final(const Params& p, const Ctx& c, int half) {
    const int gw = c.vb * 8 + c.wave, NGW = c.nvb * 8, lane = c.lane; const bf16_t* Y = (const bf16_t*)(p.ws + WS_Y); const float* WTS = (const float*)(p.ws + WS_WTS);
    for (int tl = gw; tl < HALF_T; tl += NGW) { const int t = half * HALF_T + tl; float* xr = p.out + (size_t)t * DM; f32x4 a[4];
#pragma unroll
        for (int j = 0; j < 4; ++j) a[j] = *(const f32x4*)(xr + (j >> 1) * 512 + 8 * lane + (j & 1) * 4);
        const f32x4 w0 = *(const f32x4*)(WTS + (size_t)t * TOPK), w1 = *(const f32x4*)(WTS + (size_t)t * TOPK + 4);
        const float wk[8] = {w0.x, w0.y, w0.z, w0.w, w1.x, w1.y, w1.z, w1.w};
#pragma unroll
        for (int k = 0; k < TOPK; ++k) { const bf16_t* yr = Y + ((size_t)tl * TOPK + k) * DM;
#pragma unroll
            for (int j = 0; j < 2; ++j) { const u32x4 y = *(const u32x4*)(yr + j * 512 + 8 * lane);
                a[2 * j].x += wk[k] * bflo(y.x); a[2 * j].y += wk[k] * bfhi(y.x); a[2 * j].z += wk[k] * bflo(y.y); a[2 * j].w += wk[k] * bfhi(y.y);
                a[2 * j + 1].x += wk[k] * bflo(y.z); a[2 * j + 1].y += wk[k] * bfhi(y.z); a[2 * j + 1].z += wk[k] * bflo(y.w); a[2 * j + 1].w += wk[k] * bfhi(y.w); } }
        ln_row(a, p.ln2_g, p.ln2_b, lane);
#pragma unroll
        for (int j = 0; j < 4; ++j) *(f32x4*)(xr + (j >> 1) * 512 + 8 * lane + (j & 1) * 4) = a[j]; }
}
__device__ __forceinline__ void ph_inproj(const Params& p, const Ctx& c) {
    SchedPlain S{(const char*)(p.ws + WS_XB), (const char*)(p.ws + WS_WIN_T), DM, DM, NT / 256, NPROJ / 256, c.nvb, c.vb};
    EpiProj E{(bf16_t*)(p.ws + WS_PROJ), (const float*)(p.ws + WS_COS), (const float*)(p.ws + WS_SIN)};
    pg8::gemm_phase<EpiProj, SchedPlain, true>(c.lds, S, E, DM);
}
__device__ __forceinline__ void ph_prep(const Params& p, const Ctx& c) {
    const int ncmp = c.nvb >= 128 ? 64 : 0;
    if (ncmp) {
        SchedCmp S{(const char*)(p.ws + WS_PROJ), (const char*)(p.ws + WS_W1K_T), (const char*)(p.ws + WS_W1V_T), c.nvb, c.vb};
        EpiCmp E{(const float*)(p.ws + WS_BIASKV), p.cmp_w2_k, p.cmp_w2_v, (bf16_t*)(p.ws + WS_KC), (bf16_t*)(p.ws + WS_VC)};
        pg8::gemm_phase<EpiCmp, SchedCmp, false>(c.lds, S, E, 2048);
        __syncthreads();
    }
    if (c.vb >= ncmp) for (int u = c.vb - ncmp; u < NB * 32; u += c.nvb - ncmp) gla_prep_unit(p, c, u);
}
constexpr int Q_GLA = NB * 4, Q_NSA = NB * 2 * 32, Q_CONV = 512;
#define QUEUE_LOOP(headword, total, BODY) for (;;) { __syncthreads(); if (c.tid == 0) qb[0] = (int)__hip_atomic_fetch_add((headword), 1u, __ATOMIC_RELAXED, __HIP_MEMORY_SCOPE_AGENT); \
        __syncthreads(); const int idx = __builtin_amdgcn_readfirstlane(qb[0]); if (idx >= (total)) break; BODY; }
__device__ __forceinline__ void ph_mix(const Params& p, const Ctx& c) {
    unsigned* head = (unsigned*)(p.ws + WS_CTL) + CW_QHEAD;
    LAS int* qb = (LAS int*)(c.lds + LM_Q);
    QUEUE_LOOP(head, Q_GLA, gla_unit(p, c, idx));
    QUEUE_LOOP(head + 64, Q_NSA, nsa_unit(p, c, idx));
    QUEUE_LOOP(head + 128, Q_CONV, conv_wgu(p, c, idx * 128 + c.wave, 8, (idx + 1) * 128));
}
__device__ __forceinline__ void ph_outproj(const Params& p, const Ctx& c) {
    SchedPlain S{(const char*)(p.ws + WS_MIX), (const char*)(p.ws + WS_WO_T), DM, DM, NT / 256, DM / 256, c.nvb, c.vb};
    EpiAxpyF32 E{p.x, p.out, DM, DN_ALPHA};
    pg8::gemm_phase<EpiAxpyF32, SchedPlain, true>(c.lds, S, E, DM);
}
__device__ __forceinline__ void ph_router(const Params& p, const Ctx& c) {
    SchedPlain S{(const char*)(p.ws + WS_H1B), (const char*)(p.ws + WS_WR_T), DM, DM, NT / 256, 1, c.nvb, c.vb};
    EpiAxpyF32 E{nullptr, (float*)(p.ws + WS_LOGITS), NEXP, 0.f};
    pg8::gemm_phase<EpiAxpyF32, SchedPlain, true>(c.lds, S, E, DM);
}
__device__ __forceinline__ void ph_gemm1(const Params& p, const Ctx& c) {
    build_tables(p, c);
    { SchedMoE1 S{(const char*)(p.ws + WS_H1B), (const char*)(p.ws + WS_WGU_T), (const int*)(p.ws + WS_YROW), (const LAS unsigned*)(c.lds + LM_OFFS), (const LAS unsigned*)(c.lds + LM_TB), c.nvb, c.vb};
      EpiAct E{(bf16_t*)(p.ws + WS_ACT), true};
      pg8::gemm_phase<EpiAct, SchedMoE1, true>(c.lds, S, E, DM); }
    __syncthreads();
    { SchedPlain S{(const char*)(p.ws + WS_H1B), (const char*)(p.ws + WS_WSGU_T), DM, DM, NT / 256, 2, c.nvb, c.vb};
      EpiAct E{(bf16_t*)(p.ws + WS_ACTS), false};
      pg8::gemm_phase<EpiAct, SchedPlain, true>(c.lds, S, E, DM); }
}
__device__ __forceinline__ void ph_gemm2(const Params& p, const Ctx& c, int half) {
    build_tables(p, c);
    SchedMoE2 S{(const char*)(p.ws + WS_ACT), (const char*)(p.ws + WS_WD_T), (const LAS unsigned*)(c.lds + LM_OFFS), (const LAS unsigned*)(c.lds + LM_TB), half, c.nvb, c.vb};
    EpiY E{(bf16_t*)(p.ws + WS_Y), (const int*)(p.ws + WS_YROW), half};
    pg8::gemm_phase<EpiY, SchedMoE2, true>(c.lds, S, E, DEXP);
}
__device__ __forceinline__ void ph_sh2(const Params& p, const Ctx& c) {
    SchedPlain S{(const char*)(p.ws + WS_ACTS), (const char*)(p.ws + WS_WSD_T), DEXP, DEXP, NT / 256, DM / 256, c.nvb, c.vb};
    EpiAxpyF32 E{p.out, p.out, DM, DN_ALPHA};
    pg8::gemm_phase<EpiAxpyF32, SchedPlain, true>(c.lds, S, E, DEXP);
}
constexpr int N_PHASES = 14;
template <int PH> __device__ __forceinline__ void run_phase(const Params& p, const Ctx& c) {
    if constexpr (PH == 0) ph_prologue(p, c);
    if constexpr (PH == 1) ph_inproj(p, c);
    if constexpr (PH == 2) ph_prep(p, c);
    if constexpr (PH == 3) ph_mix(p, c);
    if constexpr (PH == 4) ph_outproj(p, c);
    if constexpr (PH == 5) { ph_ln1(p, c); conv_wd(p, c, c.vb * 8 + c.wave, c.nvb * 8, NEXP * 128); }
    if constexpr (PH == 6) ph_router(p, c);
    if constexpr (PH == 7) ph_route(p, c);
    if constexpr (PH == 8) ph_scatter(p, c);
    if constexpr (PH == 9) ph_gemm1(p, c);
    if constexpr (PH == 10) { ph_gemm2(p, c, 0); __syncthreads(); ph_sh2(p, c); }
    if constexpr (PH == 11) ph_final(p, c, 0);
    if constexpr (PH == 12) ph_gemm2(p, c, 1);
    if constexpr (PH == 13) ph_final(p, c, 1);
}
template <int PH> __global__ void __launch_bounds__(512, 2) k_phase(Params p) {
    extern __shared__ __attribute__((aligned(16))) unsigned char lds_raw[];
    Ctx c; c.lds = (LAS unsigned char*)lds_raw; c.tid = threadIdx.x; c.lane = c.tid & 63; c.wave = __builtin_amdgcn_readfirstlane(c.tid >> 6);
    c.vb = blockIdx.x; c.nvb = gridDim.x;
    run_phase<PH>(p, c);
}
__global__ void __launch_bounds__(512, 2) k_mega(Params p) {
    extern __shared__ __attribute__((aligned(16))) unsigned char lds_raw[];
    Ctx c; c.lds = (LAS unsigned char*)lds_raw; c.tid = threadIdx.x; c.lane = c.tid & 63; c.wave = __builtin_amdgcn_readfirstlane(c.tid >> 6);
    c.vb = blockIdx.x; c.nvb = gridDim.x;
    if (c.tid < 4) ((LAS unsigned*)(c.lds + LM_BARW))[c.tid] = 0u;
    __syncthreads();
    const XcdBarrier bar = xcd_barrier_post((unsigned*)(p.ws + WS_CTL) + CW_BAR, (volatile LAS unsigned*)(c.lds + LM_BARW));
    run_phase<0>(p, c); xcd_barrier(bar);
    run_phase<1>(p, c); xcd_barrier(bar);
    run_phase<2>(p, c); xcd_barrier(bar);
    run_phase<3>(p, c); xcd_barrier(bar);
    run_phase<4>(p, c); xcd_barrier(bar);
    run_phase<5>(p, c); xcd_barrier(bar);
    run_phase<6>(p, c); xcd_barrier(bar);
    run_phase<7>(p, c); xcd_barrier(bar);
    run_phase<8>(p, c); xcd_barrier(bar);
    run_phase<9>(p, c); xcd_barrier(bar);
    run_phase<10>(p, c); xcd_barrier(bar);
    run_phase<11>(p, c); xcd_barrier(bar);
    run_phase<12>(p, c); xcd_barrier(bar);
    run_phase<13>(p, c);
}
#ifndef MK_MULTI
#define MK_MULTI 0
#endif
template <int PH> static void launch_phase(const Params& p, int grid, hipStream_t stream) {
    static bool attr = false;
    if (!attr) { (void)hipFuncSetAttribute((const void*)k_phase<PH>, hipFuncAttributeMaxDynamicSharedMemorySize, LDS_BYTES); attr = true; }
    hipLaunchKernelGGL(k_phase<PH>, dim3(grid), dim3(512), LDS_BYTES, stream, p);
}
extern "C" void kernel_launch(void* const* d_in, const int* in_sizes, int n_in, void* d_out, int out_size, void* d_ws, size_t ws_size, hipStream_t stream) {
    if (n_in != 27 || ws_size < WS_END) { fprintf(stderr, "kernel_launch: unexpected inputs (n_in %d, ws %zu)\n", n_in, ws_size); return; }
    Params p{};
    p.x = (const float*)d_in[0]; p.positions = (const int*)d_in[1]; p.w_in = (const float*)d_in[2]; p.w_alpha2 = (const float*)d_in[3]; p.b_alpha = (const float*)d_in[4]; p.gla_norm_g = (const float*)d_in[5];
    p.cmp_pos_k = (const float*)d_in[6]; p.cmp_w1_k = (const float*)d_in[7]; p.cmp_b1_k = (const float*)d_in[8]; p.cmp_w2_k = (const float*)d_in[9];
    p.cmp_pos_v = (const float*)d_in[10]; p.cmp_w1_v = (const float*)d_in[11]; p.cmp_b1_v = (const float*)d_in[12]; p.cmp_w2_v = (const float*)d_in[13];
    p.w_out = (const float*)d_in[14]; p.ln1_g = (const float*)d_in[15]; p.ln1_b = (const float*)d_in[16]; p.w_router = (const float*)d_in[17]; p.router_bias = (const float*)d_in[18];
    p.w_exp_gate = (const float*)d_in[19]; p.w_exp_up = (const float*)d_in[20]; p.w_exp_down = (const float*)d_in[21]; p.w_sh_gate = (const float*)d_in[22]; p.w_sh_up = (const float*)d_in[23]; p.w_sh_down = (const float*)d_in[24];
    p.ln2_g = (const float*)d_in[25]; p.ln2_b = (const float*)d_in[26];
    p.out = (float*)d_out; p.ws = (unsigned char*)d_ws;
    (void)hipMemsetAsync((char*)d_ws + WS_CTL, 0, CTL_ZERO_BYTES, stream);
#if MK_MULTI
    const int grid = 256;
    launch_phase<0>(p, grid, stream); launch_phase<1>(p, grid, stream); launch_phase<2>(p, grid, stream); launch_phase<3>(p, grid, stream);
    launch_phase<4>(p, grid, stream); launch_phase<5>(p, grid, stream); launch_phase<6>(p, grid, stream); launch_phase<7>(p, grid, stream);
    launch_phase<8>(p, grid, stream); launch_phase<9>(p, grid, stream); launch_phase<10>(p, grid, stream); launch_phase<11>(p, grid, stream);
    launch_phase<12>(p, grid, stream); launch_phase<13>(p, grid, stream);
#else
    static int grid = 0;
    if (grid == 0) { int dev = 0, cus = 0;
        if (hipGetDevice(&dev) != hipSuccess || hipDeviceGetAttribute(&cus, hipDeviceAttributeMultiprocessorCount, dev) != hipSuccess || cus <= 0) cus = 256;
        (void)hipFuncSetAttribute((const void*)k_mega, hipFuncAttributeMaxDynamicSharedMemorySize, LDS_BYTES);
        grid = cus; }
    hipLaunchKernelGGL(k_mega, dim3(grid), dim3(512), LDS_BYTES, stream, p);
#endif
}
```

```cpp
#include <hip/hip_runtime.h>
#include <cstdint>
#include <cstdio>
#include <cmath>

#ifndef PROBE_ON
#define PROBE_ON 0
#define PROBE_T 3
#define PROBE_A 9
#endif
#define LAS __attribute__((address_space(3)))
#define GAS __attribute__((address_space(1)))
typedef unsigned short bf16_t;
typedef short bf16x8 __attribute__((ext_vector_type(8)));
typedef short s16x4 __attribute__((ext_vector_type(4)));
typedef float f32x2 __attribute__((ext_vector_type(2)));
typedef float f32x4 __attribute__((ext_vector_type(4)));
typedef float f32x16 __attribute__((ext_vector_type(16)));
typedef unsigned u32x2 __attribute__((ext_vector_type(2)));
typedef unsigned u32x4 __attribute__((ext_vector_type(4)));

constexpr int NB = 32, SEQ = 2048, DM = 1024, NT = NB * SEQ;
constexpr int NPROJ = 3072;
constexpr int D_IN = 2856;
constexpr int PC_GQ = 0, PC_GK = 256, PC_GV = 512, PC_GR = 1024, PC_NQ = 1536, PC_NKC = 2048, PC_NKS = 2176, PC_NKW = 2304,
              PC_NVC = 2432, PC_NVS = 2560, PC_NVW = 2688, PC_GA = 2816, PC_NG = 2832;
constexpr int OC_GQ = 0, OC_GK = 256, OC_GV = 512, OC_GA = 1024, OC_GR = 1040, OC_NQ = 1552, OC_NKC = 2064, OC_NVC = 2192,
              OC_NKS = 2320, OC_NVS = 2448, OC_NKW = 2576, OC_NVW = 2704, OC_NG = 2832;
constexpr int NEXP = 256, TOPK = 8, DEXP = 256, NPAIR = NT * TOPK;
constexpr int NSEG = 2 * NEXP;
constexpr int HALF_T = NT / 2;
constexpr float DN_ALPHA = 1.189207115002721f;
constexpr float LN_EPS = 1e-5f;
constexpr float LOG2E = 1.4426950408889634f;

constexpr size_t MiB = 1u << 20;
constexpr size_t WS_CTL = 0, CTL_ZERO_BYTES = 1 * MiB;
constexpr size_t WS_BIASKV = 1 * MiB + 131072;
constexpr size_t WS_W2K_T = 1 * MiB, WS_W2V_T = 1 * MiB + 65536;
constexpr size_t WS_COS = 2 * MiB, WS_SIN = 10 * MiB;
constexpr size_t WS_WIN_T = 18 * MiB;
constexpr size_t WS_WO_T = 24 * MiB;
constexpr size_t WS_WR_T = 26 * MiB;
constexpr size_t WS_WSGU_T = 26 * MiB + 512 * 1024;
constexpr size_t WS_WSD_T = 27 * MiB + 512 * 1024;
constexpr size_t WS_W1K_T = 28 * MiB;
constexpr size_t WS_W1V_T = 29 * MiB;
constexpr size_t WS_KC = 30 * MiB, WS_VC = 31 * MiB;
constexpr size_t WS_EIDX = 32 * MiB;
constexpr size_t WS_WTS = 34 * MiB;
constexpr size_t WS_RANK = 36 * MiB;
constexpr size_t WS_YROW = 38 * MiB;
constexpr size_t WS_EBL = 41 * MiB;
constexpr size_t WS_PROJ = 48 * MiB;
constexpr size_t WS_LOGITS = 48 * MiB;
constexpr size_t WS_ACT = 48 * MiB;
constexpr size_t WS_WD_T = 306 * MiB;
constexpr size_t WS_WGU_T = 434 * MiB;
constexpr size_t WS_Y = 434 * MiB;
constexpr size_t WS_QB = 690 * MiB, WS_KB = 722 * MiB, WS_KL = 754 * MiB;
constexpr size_t WS_H1B = 690 * MiB;
constexpr size_t WS_XB = 818 * MiB;
constexpr size_t WS_MIX = 818 * MiB;
constexpr size_t WS_ACTS = 946 * MiB;
constexpr size_t WS_END = 978 * MiB;
static_assert(WS_PROJ + (size_t)NT * NPROJ * 2 <= WS_WGU_T, "proj");
static_assert(WS_ACT + (size_t)(NPAIR + 256) * 256 * 2 <= WS_WD_T, "act");

constexpr int CW_FLAG = 0;
constexpr int CW_BAR = 4096;
constexpr int CW_CNT = 16384;
constexpr int CW_QHEAD = 20480;

__device__ __forceinline__ unsigned f2bf(float f) { unsigned u = __builtin_bit_cast(unsigned, f); return (u + 0x7fffu + ((u >> 16) & 1u)) >> 16; }
typedef __bf16 bf16x2_t __attribute__((ext_vector_type(2)));
__device__ __forceinline__ unsigned pk2(float lo, float hi) { f32x2 v = {lo, hi}; bf16x2_t b = __builtin_convertvector(v, bf16x2_t); return __builtin_bit_cast(unsigned, b); }
__device__ __forceinline__ float bf2f(unsigned short b) { return __builtin_bit_cast(float, (unsigned)b << 16); }
__device__ __forceinline__ float bflo(unsigned w) { return __builtin_bit_cast(float, w << 16); }
__device__ __forceinline__ float bfhi(unsigned w) { return __builtin_bit_cast(float, w & 0xffff0000u); }
__device__ __forceinline__ int hw_lane_() { int x = (int)__builtin_amdgcn_mbcnt_hi(~0u, __builtin_amdgcn_mbcnt_lo(~0u, 0u)); asm volatile("" : "+v"(x)); return x; }
__device__ __forceinline__ int shi_(int v, int src) { return __builtin_amdgcn_ds_bpermute(src << 2, v); }
__device__ __forceinline__ float shi_(float v, int src) { return __builtin_bit_cast(float, __builtin_amdgcn_ds_bpermute(src << 2, __builtin_bit_cast(int, v))); }
__device__ __forceinline__ unsigned shi_(unsigned v, int src) { return (unsigned)__builtin_amdgcn_ds_bpermute(src << 2, (int)v); }
template <class T> __device__ __forceinline__ T shx_(T v, int mask) { return shi_(v, hw_lane_() ^ mask); }
__device__ __forceinline__ float wave_sum(float v) {
    const int l = hw_lane_();
#pragma unroll
    for (int o = 1; o < 64; o <<= 1) v += shi_(v, l ^ o);
    return v;
}
__device__ __forceinline__ float sigmoidf_(float x) { return 1.0f / (1.0f + __expf(-x)); }
__device__ __forceinline__ float siluf_(float x) { return x / (1.0f + __expf(-x)); }
#define LDS_WAIT() asm volatile("s_waitcnt lgkmcnt(0)" ::: "memory")
#define VM_WAIT() asm volatile("s_waitcnt vmcnt(0)" ::: "memory")
#define XB_TMO      128
#define XB_XCNT(j)  (256  + 64 * (j))
#define XB_XSUB(j)  (1280 + 64 * (j))
#define XB_XGEN(j)  (2304 + 64 * (j))
#define XB_TOP      3328
#define XB_TOPGEN   3392
#define XCD_BAR_WORDS 3456
#define XB_SPIN_CAP (1u << 18)
__device__ __forceinline__ unsigned xb_ld(unsigned* p)              { return __hip_atomic_load(p, __ATOMIC_RELAXED, __HIP_MEMORY_SCOPE_AGENT); }
__device__ __forceinline__ unsigned xb_add(unsigned* p, unsigned v) { return __hip_atomic_fetch_add(p, v, __ATOMIC_RELAXED, __HIP_MEMORY_SCOPE_AGENT); }
__device__ __forceinline__ unsigned xb_xcc_id() { return (unsigned)__builtin_amdgcn_s_getreg((3 << 11) | 20) & 0xFu; }
#define XB_SPIN(cond, bar) do { unsigned _sp = 0; while (cond) { __builtin_amdgcn_s_sleep(1); \
    if ((++_sp & 255u) == 0u) { if (xb_ld(&(bar)[XB_TMO])) break; if (_sp > XB_SPIN_CAP) { atomicAdd(&(bar)[XB_TMO], 1u); break; } } } } while (0)
struct XcdBarrier { unsigned* bar; unsigned x; volatile LAS unsigned* st; };
__device__ __forceinline__ XcdBarrier xcd_barrier_post(unsigned* bar, volatile LAS unsigned* st, bool is_t0) {
    XcdBarrier b; b.bar = bar; b.x = xb_xcc_id(); b.st = st;
    if (is_t0) (void)xb_add(&bar[XB_XCNT(b.x)], 1u);
    return b;
}
__device__ __forceinline__ void xcd_barrier_complete(unsigned* bar, unsigned x, unsigned& nloc, unsigned& nx) {
    const unsigned G = gridDim.x * gridDim.y * gridDim.z;
    unsigned sum, cnt, mine, sp = 0u;
    for (;;) {
        sum = 0u; cnt = 0u; mine = 0u;
#pragma unroll
        for (unsigned j = 0; j < 16; ++j) { const unsigned c = xb_ld(&bar[XB_XCNT(j)]); sum += c; cnt += (c > 0u) ? 1u : 0u; mine = (j == x) ? c : mine; }
        if (sum == G) break;
        __builtin_amdgcn_s_sleep(1);
        if ((++sp & 255u) == 0u) { if (xb_ld(&bar[XB_TMO])) break; if (sp > XB_SPIN_CAP) { atomicAdd(&bar[XB_TMO], 1u); break; } }
    }
    nloc = mine > 0u ? mine : 1u; nx = cnt > 0u ? cnt : 1u;
}
__device__ __forceinline__ void xcd_barrier(const XcdBarrier& b, bool is_t0) {
    asm volatile("s_waitcnt vmcnt(0)" ::: "memory");
    __syncthreads();
    if (is_t0) {
        unsigned* bar = b.bar;
        __builtin_amdgcn_s_waitcnt(0);
        unsigned nloc = b.st[0], nx = b.st[1];
        if (nloc == 0u) { xcd_barrier_complete(bar, b.x, nloc, nx); b.st[0] = nloc; b.st[1] = nx; }
        const unsigned old = xb_add(&bar[XB_XSUB(b.x)], 1u);
        const unsigned gen = old / nloc;
        if (old + 1u == (gen + 1u) * nloc) {
            __builtin_amdgcn_fence(__ATOMIC_RELEASE, "agent");
            asm volatile("s_waitcnt vmcnt(0)" ::: "memory");
            const unsigned og = xb_add(&bar[XB_TOP], 1u);
            const unsigned tg = og / nx;
            if (og + 1u == (tg + 1u) * nx) xb_add(&bar[XB_TOPGEN], 1u);
            else XB_SPIN(xb_ld(&bar[XB_TOPGEN]) == tg, bar);
            __builtin_amdgcn_fence(__ATOMIC_ACQUIRE, "agent");
            xb_add(&bar[XB_XGEN(b.x)], 1u);
            asm volatile("s_waitcnt vmcnt(0)" ::: "memory");
        } else {
            XB_SPIN(xb_ld(&bar[XB_XGEN(b.x)]) == gen, bar);
            __builtin_amdgcn_fence(__ATOMIC_ACQUIRE, "agent");
            asm volatile("s_waitcnt vmcnt(0)" ::: "memory");
        }
    }
    __syncthreads();
}
namespace pg8 {
constexpr int BM = 256, BK = 64, HALF = 128, HTB = HALF * BK * 2, STAGE_BYTES = 8 * HTB;
__host__ __device__ __forceinline__ int lds_byte(int r, int c) { const int st = (r >> 4) * 2 + (c >> 5), rr = r & 15, cc = c & 31, ob = rr * 64 + cc * 2; return st * 1024 + (ob ^ (((ob >> 9) & 1) << 5)); }
__host__ __device__ __forceinline__ void stage_rc(int b, int& R, int& C) { const int st = b / 1024, sb = b % 1024, swz = sb ^ (((sb >> 9) & 1) << 5); R = (st >> 1) * 16 + swz / 64; C = (st & 1) * 32 + (swz % 64) / 2; }
__host__ __device__ __forceinline__ int perm32(int rho) { const int n = rho >> 4, i = rho & 15; return 8 * (i >> 2) + 4 * n + (i & 3); }
struct Unit { int pm, pn, a0, a1; };
template <class Epi, class Sched, bool ALIGN_EPI>
__device__ __forceinline__ void gemm_phase(LAS unsigned char* lds, const Sched& S, const Epi& E, const int K, const int wave_id) {
    int tid_ = wave_id * 64 + (int)__builtin_amdgcn_mbcnt_hi(~0u, __builtin_amdgcn_mbcnt_lo(~0u, 0u)); asm volatile("" : "+v"(tid_));
    const int tid = tid_, wid = __builtin_amdgcn_readfirstlane(tid >> 6), lane = tid & 63, wr = wid >> 2, wc = wid & 3, fr = lane & 15, fq = lane >> 4;
    const int nt = K / BK;
    unsigned voffB[2];
#pragma unroll
    for (int i = 0; i < 2; ++i) { int R, C; stage_rc(tid * 16 + i * 8192, R, C); const int Rb = Epi::PERM ? ((R & ~31) + perm32(R & 31)) : R;
        voffB[i] = (unsigned)(Rb * K + C) * 2u; }
#define PG8_AOFF(dst, unit) do { int t2_ = tid; asm volatile("" : "+v"(t2_)); _Pragma("unroll") for (int i_ = 0; i_ < 2; ++i_) { int R_, C_; stage_rc(t2_ * 16 + i_ * 8192, R_, C_); \
        dst[0][i_] = S.a_off(unit, R_, C_); dst[1][i_] = S.a_off(unit, HALF + R_, C_); } } while (0)
    const size_t kstepB = (size_t)(BK * 2), hstepB = (size_t)HALF * K * 2, kstepA = S.a_kstep();
    const unsigned ldsw = (unsigned)wid * 1024u;
    const int aoff = lds_byte(wr * 64 + fr, fq * 8), boff = lds_byte(wc * 32 + fr, fq * 8);
#define PG8_SA(b, h) (((b) * 2 + (h)) * HTB)
#define PG8_SB(b, h) ((4 + (b) * 2 + (h)) * HTB)
#define PG8_STAGE(bufoff, gbase, voff) do { _Pragma("unroll") for (int _i = 0; _i < 2; ++_i) \
        __builtin_amdgcn_global_load_lds((const unsigned*)((const char*)(gbase) + (voff)[_i]), (LAS unsigned*)(lds + (bufoff) + ldsw + _i * 8192), 16, 0, 0); } while (0)
#define PG8_LDA(dst, b, h) do { _Pragma("unroll") for (int m = 0; m < 4; ++m) _Pragma("unroll") for (int k = 0; k < 2; ++k) dst[m][k] = *(const LAS bf16x8*)(lds + PG8_SA(b, h) + aoff + m * 2048 + k * 1024); } while (0)
#define PG8_LDB(dst, b, h) do { _Pragma("unroll") for (int n = 0; n < 2; ++n) _Pragma("unroll") for (int k = 0; k < 2; ++k) dst[n][k] = *(const LAS bf16x8*)(lds + PG8_SB(b, h) + boff + n * 2048 + k * 1024); } while (0)
#define PG8_MMA(ai, bj, At, Bt) do { __builtin_amdgcn_s_setprio(1); _Pragma("unroll") for (int m = 0; m < 4; ++m) _Pragma("unroll") for (int n = 0; n < 2; ++n) _Pragma("unroll") for (int k = 0; k < 2; ++k) \
        acc[ai][bj][m][n] = __builtin_amdgcn_mfma_f32_16x16x32_bf16(Bt[n][k], At[m][k], acc[ai][bj][m][n], 0, 0, 0); __builtin_amdgcn_s_setprio(0); } while (0)
#define PG8_WAIT_V(n) asm volatile("s_waitcnt vmcnt(" #n ")" ::: "memory")
#define PG8_WAIT_L(n) asm volatile("s_waitcnt lgkmcnt(" #n ")" ::: "memory")
#define PG8_BAR __builtin_amdgcn_s_barrier()
#define PG8_SCHED __builtin_amdgcn_sched_barrier(0)
    Unit cur, nxt; int ui = 0;
    if (!S.next(0, cur)) return;
    f32x4 acc[2][2][4][2];
#pragma unroll
    for (int a = 0; a < 2; ++a)
#pragma unroll
        for (int b = 0; b < 2; ++b)
#pragma unroll
            for (int m = 0; m < 4; ++m)
#pragma unroll
                for (int n = 0; n < 2; ++n) acc[a][b][m][n] = (f32x4){0.f, 0.f, 0.f, 0.f};
    bf16x8 At[4][2], B0[2][2], B1[2][2];
    unsigned vC[2][2], vN[2][2];
    PG8_AOFF(vC, cur);
    const char* cA = S.a_base(cur); const char* cB = S.b_base(cur);
    PG8_STAGE(PG8_SB(0, 0), cB, voffB); PG8_STAGE(PG8_SB(0, 1), cB + hstepB, voffB); PG8_STAGE(PG8_SA(0, 0), cA, vC[0]); PG8_STAGE(PG8_SA(0, 1), cA, vC[1]);
    if (wr == 1) PG8_BAR;
    PG8_WAIT_V(2); PG8_BAR;
    PG8_STAGE(PG8_SB(1, 0), cB + kstepB, voffB); PG8_STAGE(PG8_SA(1, 0), cA + kstepA, vC[0]); PG8_STAGE(PG8_SB(1, 1), cB + hstepB + kstepB, voffB);
    PG8_WAIT_V(6); PG8_BAR;
    for (;;) {
        const bool has_next = S.next(ui + 1, nxt);
        const char* nA = has_next ? S.a_base(nxt) : cA; const char* nB = has_next ? S.b_base(nxt) : cB;
        if (has_next) { PG8_AOFF(vN, nxt); } else {
#pragma unroll
            for (int h = 0; h < 2; ++h)
#pragma unroll
                for (int i = 0; i < 2; ++i) vN[h][i] = vC[h][i]; }
#pragma nounroll
        for (int t = 0; t < nt; t += 2) {
            const bool last = (t == nt - 2);
            const char* a1 = cA + (size_t)(t + 1) * kstepA;
            const char* a2 = last ? nA : cA + (size_t)(t + 2) * kstepA; const char* b2 = last ? nB : cB + (size_t)(t + 2) * kstepB;
            const char* a3 = a2 + kstepA; const char* b3 = b2 + kstepB;
            unsigned v2[2][2];
#pragma unroll
            for (int h = 0; h < 2; ++h)
#pragma unroll
                for (int i = 0; i < 2; ++i) v2[h][i] = last ? vN[h][i] : vC[h][i];
            PG8_LDB(B0, 0, 0); PG8_LDB(B1, 0, 1); PG8_SCHED; PG8_LDA(At, 0, 0); PG8_STAGE(PG8_SA(1, 1), a1, vC[1]);
            PG8_WAIT_V(8); PG8_WAIT_L(0); PG8_BAR; PG8_MMA(0, 0, At, B0); PG8_MMA(0, 1, At, B1); PG8_BAR; PG8_SCHED;
            PG8_LDA(At, 0, 1); PG8_STAGE(PG8_SB(0, 0), b2, voffB); PG8_STAGE(PG8_SB(0, 1), b2 + hstepB, voffB); PG8_STAGE(PG8_SA(0, 0), a2, v2[0]);
            PG8_WAIT_V(8); PG8_WAIT_L(0); PG8_BAR; PG8_MMA(1, 0, At, B0); PG8_MMA(1, 1, At, B1); PG8_BAR; PG8_SCHED;
            PG8_LDB(B0, 1, 0); PG8_LDB(B1, 1, 1); PG8_SCHED; PG8_LDA(At, 1, 0); PG8_STAGE(PG8_SA(0, 1), a2, v2[1]);
            PG8_WAIT_V(8); PG8_WAIT_L(0); PG8_BAR; PG8_MMA(0, 0, At, B0); PG8_MMA(0, 1, At, B1); PG8_BAR; PG8_SCHED;
            PG8_LDA(At, 1, 1); PG8_STAGE(PG8_SB(1, 0), b3, voffB); PG8_STAGE(PG8_SB(1, 1), b3 + hstepB, voffB); PG8_STAGE(PG8_SA(1, 0), a3, v2[0]);
            PG8_WAIT_V(8); PG8_WAIT_L(0); PG8_BAR; PG8_MMA(1, 0, At, B0); PG8_MMA(1, 1, At, B1); PG8_BAR; PG8_SCHED;
        }
        if constexpr (ALIGN_EPI) { if (wr == 0) PG8_BAR; }
        if constexpr (!Epi::AFTER_DRAIN) { E(acc, cur, wr, wc, fr, fq); }
        if (!has_next) break;
#pragma unroll
        for (int a = 0; a < 2; ++a)
#pragma unroll
            for (int b = 0; b < 2; ++b)
#pragma unroll
                for (int m = 0; m < 4; ++m)
#pragma unroll
                    for (int n = 0; n < 2; ++n) acc[a][b][m][n] = (f32x4){0.f, 0.f, 0.f, 0.f};
        cur = nxt; cA = nA; cB = nB; ++ui;
#pragma unroll
        for (int h = 0; h < 2; ++h)
#pragma unroll
            for (int i = 0; i < 2; ++i) vC[h][i] = vN[h][i];
        if constexpr (ALIGN_EPI) { if (wr == 1) PG8_BAR; }
    }
    PG8_WAIT_V(0);
    if constexpr (!ALIGN_EPI) { if (wr == 0) PG8_BAR; }
    PG8_BAR;
    if constexpr (Epi::AFTER_DRAIN) { E.fused(acc, cur, wr, wc, fr, fq, lds, wid, lane); }
#undef PG8_AOFF
#undef PG8_SA
#undef PG8_SB
#undef PG8_STAGE
#undef PG8_LDA
#undef PG8_LDB
#undef PG8_MMA
#undef PG8_WAIT_V
#undef PG8_WAIT_L
#undef PG8_BAR
#undef PG8_SCHED
}
}
struct Params {
    const float* x; const int* positions; const float* w_in; const float* w_alpha2; const float* b_alpha; const float* gla_norm_g;
    const float* cmp_pos_k; const float* cmp_w1_k; const float* cmp_b1_k; const float* cmp_w2_k;
    const float* cmp_pos_v; const float* cmp_w1_v; const float* cmp_b1_v; const float* cmp_w2_v;
    const float* w_out; const float* ln1_g; const float* ln1_b; const float* w_router; const float* router_bias;
    const float* w_exp_gate; const float* w_exp_up; const float* w_exp_down; const float* w_sh_gate; const float* w_sh_up; const float* w_sh_down;
    const float* ln2_g; const float* ln2_b;
    float* out; unsigned char* ws;
};
#define HW_LANE() hw_lane_()
struct Ctx { int wave, vb, nvb; LAS unsigned char* lds;
    __device__ __forceinline__ int lane() const { return HW_LANE(); }
    __device__ __forceinline__ int tid() const { return wave * 64 + HW_LANE(); } };

__device__ __forceinline__ int rope_od(int cc) { return (cc >> 1) + 32 * (cc & 1); }
__device__ __forceinline__ int proj_src(int pc, float& sc) {
    sc = 1.f;
    if (pc < 256) { sc = 0.125f; return OC_GQ + pc; }
    if (pc < 512) return OC_GK + (pc - 256);
    if (pc < 1024) return OC_GV + (pc - 512);
    if (pc < 1536) return OC_GR + (pc - 1024);
    if (pc < 2048) { const int c = pc - 1536; sc = 0.125f * LOG2E; return OC_NQ + (c & ~63) + rope_od(c & 63); }
    if (pc < 2176) { const int c = pc - 2048; return OC_NKC + (c & ~63) + rope_od(c & 63); }
    if (pc < 2304) { const int c = pc - 2176; return OC_NKS + (c & ~63) + rope_od(c & 63); }
    if (pc < 2432) { const int c = pc - 2304; return OC_NKW + (c & ~63) + rope_od(c & 63); }
    if (pc < 2560) return OC_NVC + (pc - 2432);
    if (pc < 2688) return OC_NVS + (pc - 2560);
    if (pc < 2816) return OC_NVW + (pc - 2688);
    if (pc < 2832) return OC_GA + (pc - 2816);
    if (pc < 2856) return OC_NG + (pc - 2832);
    return -1;
}
struct SrcWin { const float* W; __device__ __forceinline__ float operator()(int k, int n) const { float sc; const int oc = proj_src(n, sc); return oc < 0 ? 0.f : W[(size_t)k * D_IN + oc] * sc; } };
struct SrcPlain { const float* W; int ld; __device__ __forceinline__ float operator()(int k, int n) const { return W[(size_t)k * ld + n]; } };
struct SrcGU { const float* G; const float* U; __device__ __forceinline__ float operator()(int k, int n) const { return (n & 1) ? U[(size_t)k * DEXP + (n >> 1)] : G[(size_t)k * DEXP + (n >> 1)]; } };
struct SrcW2K { const float* W; __device__ __forceinline__ float operator()(int k, int n) const { return W[(size_t)k * 64 + rope_od(n)]; } };
struct SrcW1K { const float* W; __device__ __forceinline__ float operator()(int k, int n) const { const int kr = (k & ~63) + rope_od(k & 63); return W[(size_t)kr * 256 + n]; } };
template <class Src> __device__ __forceinline__ void tr_item(const Src& src, bf16_t* WT, int ldt, int k0, int n0, LAS float* scr, int lane) {
#pragma unroll 8
    for (int i = 0; i < 32; ++i) { const int kk = 2 * i + (lane >> 5); scr[kk * 33 + (lane & 31)] = src(k0 + kk, n0 + (lane & 31)); }
    LDS_WAIT(); asm volatile("" ::: "memory");
    const int c = lane & 7;
#pragma unroll
    for (int j = 0; j < 4; ++j) { const int n = (lane >> 3) + 8 * j; const LAS float* s = scr + (8 * c) * 33 + n;
        u32x4 o; o.x = pk2(s[0 * 33], s[1 * 33]); o.y = pk2(s[2 * 33], s[3 * 33]); o.z = pk2(s[4 * 33], s[5 * 33]); o.w = pk2(s[6 * 33], s[7 * 33]);
        *(u32x4*)(WT + (size_t)(n0 + n) * ldt + k0 + 8 * c) = o; }
    LDS_WAIT(); asm volatile("" ::: "memory");
}
template <class Src> __device__ __forceinline__ void tr_matrix(const Src& src, bf16_t* WT, int K, int N, LAS float* scr, int lane, int gw, int NGW, int& cursor) {
    const int nblk = N / 32, nit = (K / 64) * nblk;
    int first = (gw - cursor % NGW + NGW) % NGW;
    for (int it = first; it < nit; it += NGW) tr_item(src, WT, K, 64 * (it / nblk), 32 * (it % nblk), scr, lane);
    cursor += nit;
}

__device__ __forceinline__ void ph_prologue(const Params& p, const Ctx& c) {
    LAS float* scr = (LAS float*)(c.lds + c.wave * 8704);
    const int gw = c.vb * 8 + c.wave, NGW = c.nvb * 8;
    unsigned char* ws = p.ws;
    int cur = 0;
    tr_matrix(SrcWin{p.w_in}, (bf16_t*)(ws + WS_WIN_T), DM, NPROJ, scr, c.lane(), gw, NGW, cur);
    tr_matrix(SrcPlain{p.w_out, DM}, (bf16_t*)(ws + WS_WO_T), DM, DM, scr, c.lane(), gw, NGW, cur);
    tr_matrix(SrcPlain{p.w_router, NEXP}, (bf16_t*)(ws + WS_WR_T), DM, NEXP, scr, c.lane(), gw, NGW, cur);
    tr_matrix(SrcGU{p.w_sh_gate, p.w_sh_up}, (bf16_t*)(ws + WS_WSGU_T), DM, 2 * DEXP, scr, c.lane(), gw, NGW, cur);
    tr_matrix(SrcPlain{p.w_sh_down, DM}, (bf16_t*)(ws + WS_WSD_T), DEXP, DM, scr, c.lane(), gw, NGW, cur);
    tr_matrix(SrcW1K{p.cmp_w1_k}, (bf16_t*)(ws + WS_W1K_T), 2048, 256, scr, c.lane(), gw, NGW, cur);
    tr_matrix(SrcPlain{p.cmp_w1_v, 256}, (bf16_t*)(ws + WS_W1V_T), 2048, 256, scr, c.lane(), gw, NGW, cur);
    tr_matrix(SrcW2K{p.cmp_w2_k}, (bf16_t*)(ws + WS_W2K_T), 256, 64, scr, c.lane(), gw, NGW, cur);
    tr_matrix(SrcPlain{p.cmp_w2_v, 64}, (bf16_t*)(ws + WS_W2V_T), 256, 64, scr, c.lane(), gw, NGW, cur);
    const size_t gt = (size_t)c.vb * 512 + c.tid(), NGT = (size_t)c.nvb * 512;
    { const f32x4* xs = (const f32x4*)p.x; u32x4* xd = (u32x4*)(ws + WS_XB);
      for (size_t i = gt; i < (size_t)NT * DM / 8; i += NGT) { const f32x4 a = xs[2 * i], b = xs[2 * i + 1]; u32x4 o; o.x = pk2(a.x, a.y); o.y = pk2(a.z, a.w); o.z = pk2(b.x, b.y); o.w = pk2(b.z, b.w); xd[i] = o; } }
    { float* cs = (float*)(ws + WS_COS); float* sn = (float*)(ws + WS_SIN);
      for (size_t i = gt; i < (size_t)NT * 32; i += NGT) { const int t = (int)(i >> 5), f = (int)(i & 31);
        const float inv = powf(10000.0f, -(float)f / 32.0f); const float ang = (float)p.positions[t] * inv; float s, co; sincosf(ang, &s, &co); cs[i] = co; sn[i] = s; } }
    if (c.vb < 64) { const int t = c.tid(), which = t >> 8, j = t & 255, m0 = c.vb * 32; const float* pos = which ? p.cmp_pos_v : p.cmp_pos_k; const float* w1 = which ? p.cmp_w1_v : p.cmp_w1_k;
        float a = 0.f;
#pragma unroll
        for (int m = 0; m < 32; ++m) a += pos[m0 + m] * w1[(size_t)(m0 + m) * 256 + j];
        ((float*)(ws + WS_BIASKV))[c.vb * 512 + t] = a; }
}
__device__ __forceinline__ void conv_wgu(const Params& p, const Ctx& c, int first_wave, int nwaves_total, int it_end) {
    LAS float* scr = (LAS float*)(c.lds + c.wave * 8704);
    constexpr int PER = (DM / 64) * (2 * DEXP / 32);
    for (int it = first_wave; it < it_end; it += nwaves_total) { const int e = it / PER, r = it % PER;
        tr_item(SrcGU{p.w_exp_gate + (size_t)e * DM * DEXP, p.w_exp_up + (size_t)e * DM * DEXP}, (bf16_t*)(p.ws + WS_WGU_T) + (size_t)e * 2 * DEXP * DM, DM, 64 * (r / 16), 32 * (r % 16), scr, c.lane()); }
}
__device__ __forceinline__ void conv_wd(const Params& p, const Ctx& c, int first_wave, int nwaves_total, int it_end) {
    LAS float* scr = (LAS float*)(c.lds + c.wave * 8704);
    constexpr int PER = (DEXP / 64) * (DM / 32);
    for (int it = first_wave; it < it_end; it += nwaves_total) { const int e = it / PER, r = it % PER;
        tr_item(SrcPlain{p.w_exp_down + (size_t)e * DEXP * DM, DM}, (bf16_t*)(p.ws + WS_WD_T) + (size_t)e * DM * DEXP, DEXP, 64 * (r / 32), 32 * (r % 32), scr, c.lane()); }
}
struct SchedPlain {
    const char* A; const char* Bt; int lda, K, nM, nN, G, c;
    __device__ __forceinline__ bool next(int i, pg8::Unit& u) const {
        const long L = (long)i * G + c; const int nwg = nM * nN; if (L >= nwg) return false;
        int wgid = (int)L; { const int q = nwg / 8, r = nwg % 8, xcd = wgid % 8, off = wgid / 8; wgid = (xcd < r ? xcd * (q + 1) : r * (q + 1) + (xcd - r) * q) + off; }
        const int nig = 8 * nN, gid = wgid / nig, fm = gid * 8, gsz = (nM - fm) < 8 ? (nM - fm) : 8;
        u.pm = fm + ((wgid % nig) % gsz); u.pn = (wgid % nig) / gsz; u.a0 = 0; u.a1 = 0; return true;
    }
    __device__ __forceinline__ const char* a_base(const pg8::Unit& u) const { return A + (size_t)u.pm * 256 * lda * 2; }
    __device__ __forceinline__ unsigned a_off(const pg8::Unit&, int row, int C) const { return (unsigned)(row * lda + C) * 2u; }
    __device__ __forceinline__ size_t a_kstep() const { return 128; }
    __device__ __forceinline__ const char* b_base(const pg8::Unit& u) const { return Bt + (size_t)u.pn * 256 * K * 2; }
};
struct SchedCmp {
    const char* proj; const char* W1k; const char* W1v; int G, c;
    __device__ __forceinline__ bool next(int i, pg8::Unit& u) const { const int L = i * G + c; if (L >= 64) return false; u.pm = L >> 1; u.a0 = L & 1; u.pn = 0; u.a1 = 0; return true; }
    __device__ __forceinline__ const char* a_base(const pg8::Unit& u) const { return proj + ((size_t)u.pm * SEQ * NPROJ + (u.a0 ? PC_NVC : PC_NKC)) * 2; }
    __device__ __forceinline__ unsigned a_off(const pg8::Unit&, int row, int C) const { return (unsigned)((row & 127) * 16 * NPROJ + (row >> 7) * 64 + C) * 2u; }
    __device__ __forceinline__ size_t a_kstep() const { return (size_t)NPROJ * 2; }
    __device__ __forceinline__ const char* b_base(const pg8::Unit& u) const { return u.a0 ? W1v : W1k; }
};

struct EpiProj {
    static constexpr bool PERM = true, AFTER_DRAIN = false;
    bf16_t* O; const float* cs; const float* sn;
    __device__ __forceinline__ void operator()(const f32x4 (&acc)[2][2][4][2], const pg8::Unit& u, int wr, int wc, int fr, int fq) const {
        const int row0 = u.pm * 256 + wr * 64 + fr, pn = u.pn;
        const int nb = (pn >= 6 && pn <= 8) ? 2 : ((pn == 9) ? 1 : 0);
#pragma unroll
        for (int am = 0; am < 4; ++am) { const int ai = am >> 1;
            f32x4 c4[4][2], s4[4][2];
#pragma unroll
            for (int m = 2 * (am & 1); m < 2 * (am & 1) + 2; ++m)
#pragma unroll
                for (int bj = 0; bj < 2; ++bj) if (bj < nb) { const int row = row0 + ai * 128 + m * 16, i0 = ((bj * 128 + wc * 32 + 8 * fq) & 63) >> 1;
                    c4[m][bj] = *(const f32x4*)(cs + (size_t)row * 32 + i0); s4[m][bj] = *(const f32x4*)(sn + (size_t)row * 32 + i0); }
#pragma unroll
            for (int m = 2 * (am & 1); m < 2 * (am & 1) + 2; ++m) { const int row = row0 + ai * 128 + m * 16;
#pragma unroll
                for (int bj = 0; bj < 2; ++bj) { const int col0 = pn * 256 + bj * 128 + wc * 32 + 8 * fq;
                    f32x4 v0 = acc[ai][bj][m][0], v1 = acc[ai][bj][m][1];
                    if (bj < nb) { const f32x4 cc = c4[m][bj], ss = s4[m][bj];
                        v0 = (f32x4){v0[0] * cc[0] - v0[1] * ss[0], v0[1] * cc[0] + v0[0] * ss[0], v0[2] * cc[1] - v0[3] * ss[1], v0[3] * cc[1] + v0[2] * ss[1]};
                        v1 = (f32x4){v1[0] * cc[2] - v1[1] * ss[2], v1[1] * cc[2] + v1[0] * ss[2], v1[2] * cc[3] - v1[3] * ss[3], v1[3] * cc[3] + v1[2] * ss[3]}; }
                    u32x4 w; w.x = pk2(v0[0], v0[1]); w.y = pk2(v0[2], v0[3]); w.z = pk2(v1[0], v1[1]); w.w = pk2(v1[2], v1[3]);
                    *(u32x4*)(O + (size_t)row * NPROJ + col0) = w; } } }
    }
};
struct EpiAxpyF32 {
    static constexpr bool PERM = false, AFTER_DRAIN = false;
    const float* base; float* out; int ldc; float alpha;
    __device__ __forceinline__ void operator()(const f32x4 (&acc)[2][2][4][2], const pg8::Unit& u, int wr, int wc, int fr, int fq) const {
        const int row0 = u.pm * 256 + wr * 64 + fr;
#pragma unroll
        for (int ai = 0; ai < 2; ++ai)
#pragma unroll
            for (int m = 0; m < 4; ++m) { const size_t ro = (size_t)(row0 + ai * 128 + m * 16) * ldc;
#pragma unroll
                for (int bj = 0; bj < 2; ++bj)
#pragma unroll
                    for (int n = 0; n < 2; ++n) { const int col = u.pn * 256 + bj * 128 + wc * 32 + n * 16 + 4 * fq;
                        f32x4 o = acc[ai][bj][m][n]; if (base) { const f32x4 b = *(const f32x4*)(base + ro + col); o = b * alpha + o; }
                        *(f32x4*)(out + ro + col) = o; } }
    }
};
__device__ __forceinline__ float gelu_tanh(float x) { const float u = 0.7978845608028654f * (x + 0.044715f * x * x * x); const float e = __expf(2.f * u); const float t = 1.f - 2.f / (e + 1.f); return 0.5f * x * (1.f + t); }
struct EpiCmp {
    static constexpr bool PERM = false, AFTER_DRAIN = true;
    const LAS float* bias; const bf16_t* w2kt; const bf16_t* w2vt; bf16_t* kc; bf16_t* vc;
    __device__ __forceinline__ void fused(f32x4 (&acc)[2][2][4][2], const pg8::Unit& u, int wr, int wc, int fr, int fq, LAS unsigned char* lds, int wid, int lane) const {
        const int which = u.a0;
#pragma unroll
        for (int bj = 0; bj < 2; ++bj)
#pragma unroll
            for (int n = 0; n < 2; ++n) { const int col = bj * 128 + wc * 32 + n * 16 + 4 * fq; const f32x4 bv = *(const LAS f32x4*)(bias + col);
#pragma unroll
                for (int ai = 0; ai < 2; ++ai)
#pragma unroll
                    for (int m = 0; m < 4; ++m) { const int row = ai * 128 + wr * 64 + m * 16 + fr; const f32x4 v = acc[ai][bj][m][n] + bv;
                        u32x2 o; o.x = pk2(gelu_tanh(v[0]), gelu_tanh(v[1])); o.y = pk2(gelu_tanh(v[2]), gelu_tanh(v[3]));
                        *(LAS u32x2*)(lds + row * 512 + (((col >> 3) ^ (row & 15)) << 4) + (col & 7) * 2) = o; } }
        LDS_WAIT(); __syncthreads();
        const int r32 = lane & 31, h = lane >> 5, row = wid * 32 + r32;
        const bf16_t* w2t = which ? w2vt : w2kt;
        f32x16 o0 = {}, o1 = {};
#pragma unroll 4
        for (int s = 0; s < 16; ++s) { const bf16x8 hb = *(const LAS bf16x8*)(lds + row * 512 + (((2 * s + h) ^ (row & 15)) << 4));
            const bf16x8 w0 = *(const bf16x8*)(w2t + (size_t)r32 * 256 + 16 * s + 8 * h), w1 = *(const bf16x8*)(w2t + (size_t)(32 + r32) * 256 + 16 * s + 8 * h);
            o0 = __builtin_amdgcn_mfma_f32_32x32x16_bf16(w0, hb, o0, 0, 0, 0); o1 = __builtin_amdgcn_mfma_f32_32x32x16_bf16(w1, hb, o1, 0, 0, 0); }
        const int g = row >> 7, n = row & 127; bf16_t* dst = (which ? vc : kc) + ((size_t)(u.pm * 2 + g) * 128 + n) * 64;
        const float keep = (n == 127) ? 0.f : 1.f;
#pragma unroll
        for (int rq = 0; rq < 4; ++rq) { u32x2 a, b; a.x = pk2(o0[4 * rq] * keep, o0[4 * rq + 1] * keep); a.y = pk2(o0[4 * rq + 2] * keep, o0[4 * rq + 3] * keep);
            b.x = pk2(o1[4 * rq] * keep, o1[4 * rq + 1] * keep); b.y = pk2(o1[4 * rq + 2] * keep, o1[4 * rq + 3] * keep);
            *(u32x2*)(dst + 8 * rq + 4 * h) = a; *(u32x2*)(dst + 32 + 8 * rq + 4 * h) = b; }
        __syncthreads();
    }
};
typedef short v4i16_t __attribute__((ext_vector_type(4)));
__device__ __forceinline__ s16x4 tr_rd(const LAS unsigned char* p) { return __builtin_bit_cast(s16x4, __builtin_amdgcn_ds_read_tr16_b64_v4i16((LAS v4i16_t*)p)); }
__device__ __forceinline__ bf16x8 cat8(s16x4 lo, s16x4 hi) { return (bf16x8){lo[0], lo[1], lo[2], lo[3], hi[0], hi[1], hi[2], hi[3]}; }
#define MFMA32(a, b, c) __builtin_amdgcn_mfma_f32_32x32x16_bf16((a), (b), (c), 0, 0, 0)
__device__ __forceinline__ bf16x8 ld16(const LAS unsigned char* p) { return *(const LAS bf16x8*)p; }

__device__ __forceinline__ void gla_prep_unit(const Params& p, const Ctx& c, int unit) {
    LAS bf16_t* Tq = (LAS bf16_t*)c.lds; LAS bf16_t* Tk = Tq + 16384; LAS bf16_t* Tl = Tk + 16384;
    LAS float* ga = (LAS float*)(c.lds + 98304); LAS float* tot = ga + 1024;
    const bf16_t* proj = (const bf16_t*)(p.ws + WS_PROJ);
    const size_t row0 = (size_t)unit * 64;
#pragma unroll
    for (int k = 0; k < 4; ++k) { const int idx = c.tid() + 512 * k, r = idx >> 5, ch = idx & 31;
        *(LAS u32x4*)(Tq + r * 256 + ch * 8) = *(const u32x4*)(proj + (row0 + r) * NPROJ + PC_GQ + ch * 8);
        *(LAS u32x4*)(Tk + r * 256 + ch * 8) = *(const u32x4*)(proj + (row0 + r) * NPROJ + PC_GK + ch * 8); }
    for (int i = c.tid(); i < 1024; i += 512) ga[i] = bf2f(proj[(row0 + (i >> 4)) * NPROJ + PC_GA + (i & 15)]);
    const int col = c.tid() & 255, half = c.tid() >> 8;
    float w[16];
#pragma unroll
    for (int k = 0; k < 16; ++k) w[k] = p.w_alpha2[k * 256 + col];
    const float bal = p.b_alpha[col];
    LDS_WAIT(); __syncthreads();
    float bl[32]; float csum = 0.f;
#pragma unroll
    for (int r = 0; r < 32; ++r) { const LAS float* g = ga + (half * 32 + r) * 16; float z = bal;
#pragma unroll
        for (int k = 0; k < 16; ++k) z += g[k] * w[k];
        const float ls = fminf(z, 0.f) - __logf(1.0f + __expf(-fabsf(z)));
        csum += ls * (1.0f / 16.0f); bl[r] = csum; }
    if (half == 0) tot[col] = csum;
    __syncthreads();
    const float off = half ? tot[col] : 0.f;
    __syncthreads();
    if (half == 1) tot[col] = csum + off;
    __syncthreads();
    const float blast = tot[col];
#pragma unroll
    for (int r = 0; r < 32; ++r) { const float b = bl[r] + off; const int rr = half * 32 + r;
        const float q = bf2f(Tq[rr * 256 + col]), k = bf2f(Tk[rr * 256 + col]);
        Tq[rr * 256 + col] = (bf16_t)f2bf(q * __expf(b)); Tk[rr * 256 + col] = (bf16_t)f2bf(k * __expf(-b)); Tl[rr * 256 + col] = (bf16_t)f2bf(k * __expf(blast - b)); }
    if (half == 0) ((float*)(p.ws + WS_EBL))[(size_t)unit * 256 + col] = __expf(blast);
    LDS_WAIT(); __syncthreads();
    bf16_t* QB = (bf16_t*)(p.ws + WS_QB); bf16_t* KB = (bf16_t*)(p.ws + WS_KB); bf16_t* KL = (bf16_t*)(p.ws + WS_KL);
#pragma unroll
    for (int k = 0; k < 4; ++k) { const int idx = c.tid() + 512 * k, r = idx >> 5, ch = idx & 31;
        *(u32x4*)(QB + (row0 + r) * 256 + ch * 8) = *(const LAS u32x4*)(Tq + r * 256 + ch * 8);
        *(u32x4*)(KB + (row0 + r) * 256 + ch * 8) = *(const LAS u32x4*)(Tk + r * 256 + ch * 8);
        *(u32x4*)(KL + (row0 + r) * 256 + ch * 8) = *(const LAS u32x4*)(Tl + r * 256 + ch * 8); }
    LDS_WAIT(); __syncthreads();
}

constexpr int GL_QB = 0, GL_KB = 9216, GL_KL = 18432, GL_V = 26624, GL_ATT = 43008, GL_ST = 52224, GL_O = 70656, GL_EB = 104448, GL_END = 104704;
__device__ __forceinline__ void gla_unit(const Params& p, const Ctx& c, int unit) {
    const int b = unit >> 2, hd = unit & 3;
    LAS unsigned char* L = c.lds;
    const int tid = c.tid(), lane = c.lane(), w = c.wave, r32 = lane & 31, h = lane >> 5, gi = (lane >> 4) & 1, li = lane & 15;
    const bf16_t* QB = (const bf16_t*)(p.ws + WS_QB); const bf16_t* KB = (const bf16_t*)(p.ws + WS_KB); const bf16_t* KL = (const bf16_t*)(p.ws + WS_KL);
    const bf16_t* proj = (const bf16_t*)(p.ws + WS_PROJ); const float* EBL = (const float*)(p.ws + WS_EBL);
    bf16_t* MIX = (bf16_t*)(p.ws + WS_MIX);
    const int ci = w >> 2, ei = w & 3;
    const int lr = tid >> 3, lch = tid & 7;
    u32x4 pq, pk, pl, pv0, pv1; float peb = 0.f;
    auto gload = [&](int chunk) {
        const size_t row = (size_t)b * SEQ + chunk * 64;
        pq = *(const u32x4*)(QB + (row + lr) * 256 + hd * 64 + lch * 8);
        pk = *(const u32x4*)(KB + (row + lr) * 256 + hd * 64 + lch * 8);
        pl = *(const u32x4*)(KL + (row + lr) * 256 + hd * 64 + lch * 8);
        { const int i0 = tid, i1 = tid + 512;
          pv0 = *(const u32x4*)(proj + (row + (i0 >> 4)) * NPROJ + PC_GV + hd * 128 + (i0 & 15) * 8);
          pv1 = *(const u32x4*)(proj + (row + (i1 >> 4)) * NPROJ + PC_GV + hd * 128 + (i1 & 15) * 8); }
        if (tid < 64) peb = EBL[((size_t)b * 32 + chunk) * 256 + hd * 64 + tid];
    };
    auto lstore = [&]() {
        *(LAS u32x4*)(L + GL_QB + (lr * 72 + lch * 8) * 2) = pq;
        *(LAS u32x4*)(L + GL_KB + (lr * 72 + lch * 8) * 2) = pk;
        *(LAS u32x4*)(L + GL_KL + (lch >> 2) * 4096 + lr * 64 + (lch & 3) * 16) = pl;
        { const int i0 = tid, i1 = tid + 512;
          *(LAS u32x4*)(L + GL_V + ((i0 & 15) >> 2) * 4096 + (i0 >> 4) * 64 + (i0 & 3) * 16) = pv0;
          *(LAS u32x4*)(L + GL_V + ((i1 & 15) >> 2) * 4096 + (i1 >> 4) * 64 + (i1 & 3) * 16) = pv1; }
        if (tid < 64) ((LAS float*)(L + GL_EB))[tid] = peb;
    };
    f32x16 S = {};
    gload(0); lstore(); LDS_WAIT(); __syncthreads();
    const int trA = (li >> 2) * 64 + (16 * gi + 4 * (li & 3)) * 2;
    for (int chunk = 0; chunk < 32; ++chunk) {
        if (chunk + 1 < 32) gload(chunk + 1);
#pragma unroll
        for (int rq = 0; rq < 4; ++rq) { u32x2 o2; o2.x = pk2(S[4 * rq], S[4 * rq + 1]); o2.y = pk2(S[4 * rq + 2], S[4 * rq + 3]);
            *(LAS u32x2*)(L + GL_ST + ((32 * ei + r32) * 72 + 32 * ci + 8 * rq + 4 * h) * 2) = o2; }
        if (w < 3) { const int aci = (w + 1) >> 1, acj = w >> 1;
            f32x16 a = {};
#pragma unroll
            for (int s = 0; s < 4; ++s) { const bf16x8 ka = ld16(L + GL_KB + ((32 * acj + r32) * 72 + 16 * s + 8 * h) * 2), qa = ld16(L + GL_QB + ((32 * aci + r32) * 72 + 16 * s + 8 * h) * 2);
                a = MFMA32(ka, qa, a); }
#pragma unroll
            for (int rq = 0; rq < 4; ++rq) { float v[4];
#pragma unroll
                for (int e = 0; e < 4; ++e) { const int j = 32 * acj + 8 * rq + 4 * h + e, cg = 32 * aci + r32; v[e] = (j <= cg) ? a[4 * rq + e] : 0.f; }
                u32x2 o2; o2.x = pk2(v[0], v[1]); o2.y = pk2(v[2], v[3]);
                *(LAS u32x2*)(L + GL_ATT + ((32 * aci + r32) * 72 + 32 * acj + 8 * rq + 4 * h) * 2) = o2; } }
        LDS_WAIT(); __syncthreads();
        bf16x8 vf[4];
#pragma unroll
        for (int s = 0; s < 4; ++s) { const LAS unsigned char* a0 = L + GL_V + ei * 4096 + (16 * s + 8 * h) * 64 + trA; vf[s] = cat8(tr_rd(a0), tr_rd(a0 + 256)); }
        f32x16 o = {};
#pragma unroll
        for (int s = 0; s < 4; ++s) { if (ci == 1 || s < 2) { const bf16x8 aa = ld16(L + GL_ATT + ((32 * ci + r32) * 72 + 16 * s + 8 * h) * 2); o = MFMA32(aa, vf[s], o); } }
#pragma unroll
        for (int s = 0; s < 4; ++s) { const bf16x8 qa = ld16(L + GL_QB + ((32 * ci + r32) * 72 + 16 * s + 8 * h) * 2), sb = ld16(L + GL_ST + ((32 * ei + r32) * 72 + 16 * s + 8 * h) * 2); o = MFMA32(qa, sb, o); }
        { LAS float* LO = (LAS float*)(L + GL_O);
#pragma unroll
          for (int r = 0; r < 16; ++r) LO[(32 * ci + (r & 3) + 8 * (r >> 2) + 4 * h) * 132 + 32 * ei + r32] = o[r]; }
#pragma unroll
        for (int rq = 0; rq < 4; ++rq) { const f32x4 e4 = *(const LAS f32x4*)(L + GL_EB + (32 * ci + 8 * rq + 4 * h) * 4);
#pragma unroll
            for (int e = 0; e < 4; ++e) S[4 * rq + e] *= e4[e]; }
#pragma unroll
        for (int s = 0; s < 4; ++s) { const LAS unsigned char* a0 = L + GL_KL + ci * 4096 + (16 * s + 8 * h) * 64 + trA; const bf16x8 ka = cat8(tr_rd(a0), tr_rd(a0 + 256)); S = MFMA32(ka, vf[s], S); }
        LDS_WAIT(); __syncthreads();
        { const int tok = tid >> 3, part = tid & 7; const LAS float* LO = (const LAS float*)(L + GL_O) + tok * 132 + part * 16;
          f32x4 v4[4]; float ss = 0.f;
#pragma unroll
          for (int q = 0; q < 4; ++q) { v4[q] = *(const LAS f32x4*)(LO + 4 * q); ss += v4[q].x * v4[q].x + v4[q].y * v4[q].y + v4[q].z * v4[q].z + v4[q].w * v4[q].w; }
          ss += shx_(ss, 1); ss += shx_(ss, 2); ss += shx_(ss, 4);
          const float rs = rsqrtf(ss * (1.0f / 128.0f) + 1e-6f);
          const size_t row = (size_t)b * SEQ + chunk * 64 + tok;
          const u32x4 r0 = *(const u32x4*)(proj + row * NPROJ + PC_GR + hd * 128 + part * 16), r1 = *(const u32x4*)(proj + row * NPROJ + PC_GR + hd * 128 + part * 16 + 8);
          const unsigned rw[8] = {r0.x, r0.y, r0.z, r0.w, r1.x, r1.y, r1.z, r1.w};
          unsigned ow[8];
#pragma unroll
          for (int q = 0; q < 4; ++q) { const f32x4 g4 = *(const f32x4*)(p.gla_norm_g + part * 16 + 4 * q);
              const float a0 = v4[q].x * rs * g4.x * siluf_(bflo(rw[2 * q])), a1 = v4[q].y * rs * g4.y * siluf_(bfhi(rw[2 * q]));
              const float a2 = v4[q].z * rs * g4.z * siluf_(bflo(rw[2 * q + 1])), a3 = v4[q].w * rs * g4.w * siluf_(bfhi(rw[2 * q + 1]));
              ow[2 * q] = pk2(a0, a1); ow[2 * q + 1] = pk2(a2, a3); }
          *(u32x4*)(MIX + row * DM + hd * 128 + part * 16) = (u32x4){ow[0], ow[1], ow[2], ow[3]};
          *(u32x4*)(MIX + row * DM + hd * 128 + part * 16 + 8) = (u32x4){ow[4], ow[5], ow[6], ow[7]}; }
        if (chunk + 1 < 32) lstore();
        LDS_WAIT(); __syncthreads();
    }
}
constexpr int NS_BUF = 17408, NS_K = 0, NS_V = 9216, NS_IMP = 69632, NS_SEL = NS_IMP + 32768, NS_END = NS_SEL + 256;
constexpr float ATT_THR = 8.0f;
constexpr int NB2_K = 0, NB2_V = 18432, NB2_BUF = 18432 + 16384;
#define ATT_PV(P, keyoff) _Pragma("unroll") for (int s = 0; s < 2; ++s) { u32x4 pw; pw.x = pk2(P[8 * s], P[8 * s + 1]); pw.y = pk2(P[8 * s + 2], P[8 * s + 3]); pw.z = pk2(P[8 * s + 4], P[8 * s + 5]); pw.w = pk2(P[8 * s + 6], P[8 * s + 7]); \
        const bf16x8 pf = __builtin_bit_cast(bf16x8, pw); _Pragma("unroll") for (int dh = 0; dh < 2; ++dh) { const LAS unsigned char* a0 = Vb + dh * 8192 + ((keyoff) + 16 * s + 4 * h) * 64 + trA; \
            O[dh] = MFMA32(cat8(tr_rd(a0), tr_rd(a0 + 512)), pf, O[dh]); } }
__device__ __forceinline__ void attn_tile2(const LAS unsigned char* Kb, const LAS unsigned char* Vb, const bf16x8 (&Qf)[4], int kminA, int kmaxA, int kminB, int kmaxB, bool nomask, bool first, bool useB,
                                           int r32, int h, int trA, float& m, float& l, f32x16& negm, f32x16 (&O)[2]) {
    f32x16 p0, p1, p2, p3;
#pragma unroll
    for (int s = 0; s < 4; ++s) { const bf16x8 a0 = ld16(Kb + (r32 * 72 + 16 * s + 8 * h) * 2), a1 = ld16(Kb + ((32 + r32) * 72 + 16 * s + 8 * h) * 2);
        if (s == 0) { p0 = MFMA32(a0, Qf[s], negm); p1 = MFMA32(a1, Qf[s], negm); } else { p0 = MFMA32(a0, Qf[s], p0); p1 = MFMA32(a1, Qf[s], p1); } }
    if (useB) {
#pragma unroll
        for (int s = 0; s < 4; ++s) { const bf16x8 a2 = ld16(Kb + ((64 + r32) * 72 + 16 * s + 8 * h) * 2), a3 = ld16(Kb + ((96 + r32) * 72 + 16 * s + 8 * h) * 2);
            if (s == 0) { p2 = MFMA32(a2, Qf[s], negm); p3 = MFMA32(a3, Qf[s], negm); } else { p2 = MFMA32(a2, Qf[s], p2); p3 = MFMA32(a3, Qf[s], p3); } }
    } else {
#pragma unroll
        for (int r = 0; r < 16; ++r) { p2[r] = -INFINITY; p3[r] = -INFINITY; } }
    if (!nomask) {
#pragma unroll
        for (int r = 0; r < 16; ++r) { const int ko = (r & 3) + 8 * (r >> 2) + 4 * h;
            p0[r] = (ko >= kminA && ko <= kmaxA) ? p0[r] : -INFINITY; p1[r] = (ko + 32 >= kminA && ko + 32 <= kmaxA) ? p1[r] : -INFINITY;
            p2[r] = (ko >= kminB && ko <= kmaxB) ? p2[r] : -INFINITY; p3[r] = (ko + 32 >= kminB && ko + 32 <= kmaxB) ? p3[r] : -INFINITY; } }
    float mx = fmaxf(fmaxf(p0[0], p1[0]), fmaxf(p2[0], p3[0]));
#pragma unroll
    for (int r = 1; r < 16; ++r) mx = fmaxf(mx, fmaxf(fmaxf(p0[r], p1[r]), fmaxf(p2[r], p3[r])));
    mx = fmaxf(mx, shx_(mx, 32));
    if (first || __any(mx > ATT_THR)) {
        const float d = first ? ((mx == -INFINITY) ? 0.f : mx) : fmaxf(mx, 0.f);
        m += d;
#pragma unroll
        for (int r = 0; r < 16; ++r) { p0[r] -= d; p1[r] -= d; p2[r] -= d; p3[r] -= d; negm[r] = -m; }
        asm volatile("" : "+v"(negm));
        if (!first) { const float alpha = __builtin_amdgcn_exp2f(-d); l *= alpha;
#pragma unroll
            for (int r = 0; r < 16; ++r) { O[0][r] *= alpha; O[1][r] *= alpha; } }
    }
    float rs = 0.f;
#pragma unroll
    for (int r = 0; r < 16; ++r) { p0[r] = __builtin_amdgcn_exp2f(p0[r]); p1[r] = __builtin_amdgcn_exp2f(p1[r]); rs += p0[r] + p1[r]; }
    ATT_PV(p0, 0) ATT_PV(p1, 32)
    if (useB) {
#pragma unroll
        for (int r = 0; r < 16; ++r) { p2[r] = __builtin_amdgcn_exp2f(p2[r]); p3[r] = __builtin_amdgcn_exp2f(p3[r]); rs += p2[r] + p3[r]; }
        ATT_PV(p2, 64) ATT_PV(p3, 96)
    }
    l += rs;
}

template <int MODE> __device__ __forceinline__ void nsa_fold(LAS unsigned* park, bf16_t* mixrow, const f32x16 (&O)[2], float scale, int h) {
#pragma unroll
    for (int dh = 0; dh < 2; ++dh)
#pragma unroll
        for (int rq = 0; rq < 4; ++rq) {
            float v0 = scale * O[dh][4 * rq], v1 = scale * O[dh][4 * rq + 1], v2 = scale * O[dh][4 * rq + 2], v3 = scale * O[dh][4 * rq + 3];
            if (MODE != 0) { const u32x2 old = *(const LAS u32x2*)(park + 8 * dh + 2 * rq); v0 += bflo(old.x); v1 += bfhi(old.x); v2 += bflo(old.y); v3 += bfhi(old.y); }
            u32x2 o2; o2.x = pk2(v0, v1); o2.y = pk2(v2, v3);
            if (MODE == 2) *(u32x2*)(mixrow + 32 * dh + 8 * rq + 4 * h) = o2; else *(LAS u32x2*)(park + 8 * dh + 2 * rq) = o2; }
}
__device__ __forceinline__ void nsa_unit(const Params& p, const Ctx& c, int unit) {
    const int tile = 31 - (unit >> 6), bg = unit & 63, b = bg >> 1, g = bg & 1, cur = tile, t0 = tile * 64;
    LAS unsigned char* L = c.lds;
    const int tid = c.tid(), lane = c.lane(), w = c.wave, r32 = lane & 31, h = lane >> 5, gi = (lane >> 4) & 1, li = lane & 15;
    const int hh = w >> 1, th = w & 1, hq = g * 4 + hh, qo = 32 * th + r32;
    const int trA = (li >> 2) * 64 + (16 * gi + 4 * (li & 3)) * 2;
    const bf16_t* proj = (const bf16_t*)(p.ws + WS_PROJ);
    const size_t rowb = (size_t)b * SEQ;
    const size_t qrow = rowb + t0 + qo;
    bf16x8 Qf[4];
#pragma unroll
    for (int s = 0; s < 4; ++s) Qf[s] = *(const bf16x8*)(proj + qrow * NPROJ + PC_NQ + hq * 64 + 16 * s + 8 * h);
    float g0, g1, g2;
    { const bf16_t* gp = proj + qrow * NPROJ + PC_NG + hq * 3; g0 = sigmoidf_(bf2f(gp[0])); g1 = sigmoidf_(bf2f(gp[1])); g2 = sigmoidf_(bf2f(gp[2])); }
    const int skey = tid >> 3, sch = tid & 7;
    const int kdst = (skey * 72 + sch * 8) * 2, vdst = (sch >> 2) * 4096 + skey * 64 + (sch & 3) * 16;
    u32x4 pkr, pvr;
    const bool useB = (t0 + 32) >= 1024;
    { const bf16_t* KC = (const bf16_t*)(p.ws + WS_KC) + (size_t)bg * 128 * 64; const bf16_t* VC = (const bf16_t*)(p.ws + WS_VC) + (size_t)bg * 128 * 64;
      pkr = *(const u32x4*)(KC + skey * 64 + sch * 8); pvr = *(const u32x4*)(VC + skey * 64 + sch * 8);
      *(LAS u32x4*)(L + NS_K + kdst) = pkr; *(LAS u32x4*)(L + NS_V + vdst) = pvr;
      if (useB) { pkr = *(const u32x4*)(KC + (64 + skey) * 64 + sch * 8); pvr = *(const u32x4*)(VC + (64 + skey) * 64 + sch * 8);
          *(LAS u32x4*)(L + NS_BUF + NS_K + kdst) = pkr; *(LAS u32x4*)(L + NS_BUF + NS_V + vdst) = pvr; } }
    const int nsel = cur + 1, nwin = (cur < 8 ? cur : 8) + 1, npsel = (nsel + 1) >> 1, npwin = (nwin + 1) >> 1, npair = npsel + npwin;
    u32x4 pkA, pvA, pkB, pvB;
    auto tile_j = [&](int q, int sub, bool& exists, bool& win) -> int { win = q >= npsel; const int i = 2 * (win ? q - npsel : q) + sub; exists = i < (win ? nwin : nsel);
        return win ? cur - i : (i == 0 ? cur : i - 1); };
#define NSA_GLOAD(q) do { bool exA_, exB_, w_; const int jA_ = tile_j((q), 0, exA_, w_); const int jB_ = tile_j((q), 1, exB_, w_); const int kc_ = w_ ? PC_NKW : PC_NKS, vc_ = w_ ? PC_NVW : PC_NVS; \
        pkA = *(const u32x4*)(proj + (rowb + 64 * jA_ + skey) * NPROJ + kc_ + g * 64 + sch * 8); pvA = *(const u32x4*)(proj + (rowb + 64 * jA_ + skey) * NPROJ + vc_ + g * 64 + sch * 8); \
        if (exB_) { pkB = *(const u32x4*)(proj + (rowb + 64 * jB_ + skey) * NPROJ + kc_ + g * 64 + sch * 8); pvB = *(const u32x4*)(proj + (rowb + 64 * jB_ + skey) * NPROJ + vc_ + g * 64 + sch * 8); } } while (0)
#define NSA_LSTORE(buf) do { LAS unsigned char* nb_ = L + (buf) * NB2_BUF; *(LAS u32x4*)(nb_ + NB2_K + kdst) = pkA; *(LAS u32x4*)(nb_ + NB2_K + 64 * 144 + kdst) = pkB; \
        *(LAS u32x4*)(nb_ + NB2_V + vdst2) = pvA; *(LAS u32x4*)(nb_ + NB2_V + 64 * 64 + vdst2) = pvB; } while (0)
    const int vdst2 = (sch >> 2) * 8192 + skey * 64 + (sch & 3) * 16;
    pkB = (u32x4){0u, 0u, 0u, 0u}; pvB = pkB;
    NSA_GLOAD(0);
    LDS_WAIT(); __syncthreads();
    bf16_t* mixrow = (bf16_t*)(p.ws + WS_MIX) + qrow * DM + 512 + hq * 64;
    LAS unsigned* park = (LAS unsigned*)(L + NS_IMP) + (w * 64 + lane) * 16;
    f32x16 ocmp[2];
    {
        const int t = t0 + qo; const int nmax = (t >= 31) ? ((t - 31) >> 4) : -1;
        f32x16 pa0 = {}, pa1 = {}, pb0 = {}, pb1 = {};
#pragma unroll
        for (int s = 0; s < 4; ++s) { const bf16x8 a0 = ld16(L + NS_K + (r32 * 72 + 16 * s + 8 * h) * 2), a1 = ld16(L + NS_K + ((32 + r32) * 72 + 16 * s + 8 * h) * 2);
            pa0 = MFMA32(a0, Qf[s], pa0); pa1 = MFMA32(a1, Qf[s], pa1); }
        if (useB) {
#pragma unroll
            for (int s = 0; s < 4; ++s) { const bf16x8 a0 = ld16(L + NS_BUF + NS_K + (r32 * 72 + 16 * s + 8 * h) * 2), a1 = ld16(L + NS_BUF + NS_K + ((32 + r32) * 72 + 16 * s + 8 * h) * 2);
                pb0 = MFMA32(a0, Qf[s], pb0); pb1 = MFMA32(a1, Qf[s], pb1); } }
        float mx = -INFINITY;
#pragma unroll
        for (int r = 0; r < 16; ++r) { const int n = (r & 3) + 8 * (r >> 2) + 4 * h;
            pa0[r] = (n <= nmax) ? pa0[r] : -INFINITY; pa1[r] = (n + 32 <= nmax) ? pa1[r] : -INFINITY;
            pb0[r] = (useB && n + 64 <= nmax) ? pb0[r] : -INFINITY; pb1[r] = (useB && n + 96 <= nmax) ? pb1[r] : -INFINITY;
            mx = fmaxf(fmaxf(mx, fmaxf(pa0[r], pa1[r])), fmaxf(pb0[r], pb1[r])); }
        mx = fmaxf(mx, shx_(mx, 32));
        const float ms = (mx == -INFINITY) ? 0.f : mx;
        float rs = 0.f;
#pragma unroll
        for (int r = 0; r < 16; ++r) { pa0[r] = __builtin_amdgcn_exp2f(pa0[r] - ms); pa1[r] = __builtin_amdgcn_exp2f(pa1[r] - ms); pb0[r] = __builtin_amdgcn_exp2f(pb0[r] - ms); pb1[r] = __builtin_amdgcn_exp2f(pb1[r] - ms);
            rs += (pa0[r] + pa1[r]) + (pb0[r] + pb1[r]); }
        rs += shx_(rs, 32);
        const float inv = rs > 0.f ? 1.0f / rs : 0.f;
#pragma unroll
        for (int r = 0; r < 16; ++r) { pa0[r] *= inv; pa1[r] *= inv; pb0[r] *= inv; pb1[r] *= inv; }
        { LAS float* IMP = (LAS float*)(L + NS_IMP) + ((size_t)hh * 64 + qo) * 32;
          float A[16], tl[16];
#pragma unroll
          for (int rq = 0; rq < 4; ++rq) {
              A[rq] = pa0[4 * rq] + pa0[4 * rq + 1] + pa0[4 * rq + 2] + 0.5f * pa0[4 * rq + 3]; tl[rq] = 0.5f * pa0[4 * rq + 3];
              A[4 + rq] = pa1[4 * rq] + pa1[4 * rq + 1] + pa1[4 * rq + 2] + 0.5f * pa1[4 * rq + 3]; tl[4 + rq] = 0.5f * pa1[4 * rq + 3];
              A[8 + rq] = pb0[4 * rq] + pb0[4 * rq + 1] + pb0[4 * rq + 2] + 0.5f * pb0[4 * rq + 3]; tl[8 + rq] = 0.5f * pb0[4 * rq + 3];
              A[12 + rq] = pb1[4 * rq] + pb1[4 * rq + 1] + pb1[4 * rq + 2] + 0.5f * pb1[4 * rq + 3]; tl[12 + rq] = 0.5f * pb1[4 * rq + 3]; }
          float prev = 0.f;
#pragma unroll
          for (int i = 0; i < 16; ++i) { const float ot = shx_(tl[i], 32); IMP[2 * i + h] = A[i] + (h ? ot : prev); prev = ot; } }
        f32x16 O[2]; O[0] = (f32x16){}; O[1] = (f32x16){};
#pragma unroll
        for (int tt = 0; tt < 2; ++tt) { if (tt == 0 || useB) {
#pragma unroll
            for (int hf = 0; hf < 2; ++hf)
#pragma unroll
                for (int s = 0; s < 2; ++s) { const f32x16& P = tt == 0 ? (hf == 0 ? pa0 : pa1) : (hf == 0 ? pb0 : pb1);
                    u32x4 pw; pw.x = pk2(P[8 * s], P[8 * s + 1]); pw.y = pk2(P[8 * s + 2], P[8 * s + 3]); pw.z = pk2(P[8 * s + 4], P[8 * s + 5]); pw.w = pk2(P[8 * s + 6], P[8 * s + 7]);
                    const bf16x8 pf = __builtin_bit_cast(bf16x8, pw);
#pragma unroll
                    for (int dh = 0; dh < 2; ++dh) { const LAS unsigned char* a0 = L + tt * NS_BUF + NS_V + dh * 4096 + (32 * hf + 16 * s + 4 * h) * 64 + trA;
                        O[dh] = MFMA32(cat8(tr_rd(a0), tr_rd(a0 + 512)), pf, O[dh]); } } } }
        ocmp[0] = O[0]; ocmp[1] = O[1];
    }
    LDS_WAIT(); __syncthreads();
    { const int tok = tid >> 3, sub = tid & 7; const LAS float* I0 = (const LAS float*)(L + NS_IMP) + tok * 32;
      float v[32];
#pragma unroll
      for (int q = 0; q < 8; ++q) { f32x4 s4 = *(const LAS f32x4*)(I0 + 4 * q);
#pragma unroll
          for (int hd = 1; hd < 4; ++hd) s4 += *(const LAS f32x4*)(I0 + hd * 64 * 32 + 4 * q);
          v[4 * q] = s4.x; v[4 * q + 1] = s4.y; v[4 * q + 2] = s4.z; v[4 * q + 3] = s4.w; }
#pragma unroll
      for (int k = 0; k < 32; ++k) v[k] = (k > cur) ? -INFINITY : ((k == 0 || k == cur || k == cur - 1) ? INFINITY : v[k]);
      unsigned bits = 0u;
#pragma unroll
      for (int jj = 0; jj < 4; ++jj) {
          float vj = 0.f;
#pragma unroll
          for (int k = 0; k < 32; ++k) vj = (k == 4 * sub + jj) ? v[k] : vj;
          const int j = 4 * sub + jj; int rank = 0;
#pragma unroll
          for (int k = 0; k < 32; ++k) rank += (v[k] > vj || (v[k] == vj && k < j)) ? 1 : 0;
          if (rank < 16 && j <= cur) bits |= 1u << j; }
      bits |= shx_(bits, 1); bits |= shx_(bits, 2); bits |= shx_(bits, 4);
      if (sub == 0) ((LAS unsigned*)(L + NS_SEL))[tok] = bits; }
    NSA_LSTORE(0);
    LDS_WAIT(); __syncthreads();
    nsa_fold<0>(park, mixrow, ocmp, g0, h);
    const unsigned selmask = ((const LAS unsigned*)(L + NS_SEL))[qo];
    float m = 0.f, l = 0.f; f32x16 O[2]; O[0] = (f32x16){}; O[1] = (f32x16){}; f32x16 negm = {};
    for (int q = 0; q < npair; ++q) {
        if (q + 1 < npair) NSA_GLOAD(q + 1);
        if (q == npsel) {
            const float lt = l + shx_(l, 32), inv = lt > 0.f ? g1 / lt : 0.f;
            nsa_fold<1>(park, mixrow, O, inv, h);
            O[0] = (f32x16){}; O[1] = (f32x16){}; m = 0.f; l = 0.f; negm = (f32x16){}; }
        bool exA, exB, wsel; const int jA = tile_j(q, 0, exA, wsel); const int jB = tile_j(q, 1, exB, wsel);
        const int qq = wsel ? q - npsel : q;
        int kminA = 0, kmaxA = 63, kminB = 0, kmaxB = 63; bool nomask = true, anyrow = true;
        if (!wsel) { const bool sA = (selmask >> jA) & 1u, sB = exB && ((selmask >> jB) & 1u);
            if (qq == 0) { kmaxA = qo; nomask = false; }
            if (!sA) kmaxA = -1; if (!sB) kmaxB = -1;
            if (!__all(sA && (sB || !exB))) nomask = false;
            anyrow = __any(sA || sB); }
        else { if (qq == 0) { kmaxA = qo; nomask = false; }
            if (2 * qq == 8) { kminA = qo + 1; nomask = false; } }
        const LAS unsigned char* bufp = L + (q & 1) * NB2_BUF;
        if (anyrow) attn_tile2(bufp + NB2_K, bufp + NB2_V, Qf, kminA, kmaxA, kminB, kmaxB, nomask, (qq == 0), exB, r32, h, trA, m, l, negm, O);
        if (q + 1 < npair) NSA_LSTORE((q + 1) & 1);
        LDS_WAIT(); __syncthreads();
    }
    { const float lt = l + shx_(l, 32), inv = lt > 0.f ? g2 / lt : 0.f; nsa_fold<2>(park, mixrow, O, inv, h); }
}
__device__ __forceinline__ void ln_row(f32x4 (&a)[4], const float* g, const float* bta, int lane) {
    float s = 0.f;
#pragma unroll
    for (int j = 0; j < 4; ++j) s += (a[j].x + a[j].y) + (a[j].z + a[j].w);
    const float mean = wave_sum(s) * (1.0f / DM); float q = 0.f;
#pragma unroll
    for (int j = 0; j < 4; ++j) { a[j] = a[j] - mean; q += (a[j].x * a[j].x + a[j].y * a[j].y) + (a[j].z * a[j].z + a[j].w * a[j].w); }
    const float rstd = rsqrtf(wave_sum(q) * (1.0f / DM) + LN_EPS);
#pragma unroll
    for (int j = 0; j < 4; ++j) { const int col = (j >> 1) * 512 + 8 * lane + (j & 1) * 4; const f32x4 g4 = *(const f32x4*)(g + col), b4 = *(const f32x4*)(bta + col); a[j] = a[j] * rstd * g4 + b4; }
}
__device__ __forceinline__ void ph_ln1(const Params& p, const Ctx& c) {
    const int gw = c.vb * 8 + c.wave, NGW = c.nvb * 8; bf16_t* H1B = (bf16_t*)(p.ws + WS_H1B);
    for (int row = gw; row < NT; row += NGW) { float* xr = p.out + (size_t)row * DM; f32x4 a[4];
#pragma unroll
        for (int j = 0; j < 4; ++j) a[j] = *(const f32x4*)(xr + (j >> 1) * 512 + 8 * c.lane() + (j & 1) * 4);
        ln_row(a, p.ln1_g, p.ln1_b, c.lane());
#pragma unroll
        for (int j = 0; j < 4; ++j) *(f32x4*)(xr + (j >> 1) * 512 + 8 * c.lane() + (j & 1) * 4) = a[j];
#pragma unroll
        for (int j = 0; j < 2; ++j) { u32x4 o; o.x = pk2(a[2 * j].x, a[2 * j].y); o.y = pk2(a[2 * j].z, a[2 * j].w); o.z = pk2(a[2 * j + 1].x, a[2 * j + 1].y); o.w = pk2(a[2 * j + 1].z, a[2 * j + 1].w);
            *(u32x4*)(H1B + (size_t)row * DM + j * 512 + 8 * c.lane()) = o; } }
}
__device__ __forceinline__ void ph_route(const Params& p, const Ctx& c) {
    const int lane = c.lane(), grp = lane & 7, tk = lane >> 3;
    const float* LG = (const float*)(p.ws + WS_LOGITS); int* EIDX = (int*)(p.ws + WS_EIDX); float* WTS = (float*)(p.ws + WS_WTS); int* RANK = (int*)(p.ws + WS_RANK);
    unsigned* CNT = (unsigned*)(p.ws + WS_CTL) + CW_CNT;
    LAS unsigned* lcnt = (LAS unsigned*)c.lds; LAS unsigned* lbase = lcnt + NEXP;
    constexpr int TPB = 256;
    for (int blk = c.vb; blk < NT / TPB; blk += c.nvb) {
        __syncthreads();
        if (c.tid() < NEXP) lcnt[c.tid()] = 0u;
        __syncthreads();
        const int tb0 = blk * TPB, halfoff = (tb0 >= HALF_T) ? NEXP : 0;
        for (int it = 0; it < 4; ++it) { const int t = tb0 + c.wave * 32 + it * 8 + tk;
            float val[32];
#pragma unroll
            for (int q = 0; q < 8; ++q) { const f32x4 lg = *(const f32x4*)(LG + (size_t)t * NEXP + grp * 32 + 4 * q), rb = *(const f32x4*)(p.router_bias + grp * 32 + 4 * q);
#pragma unroll
                for (int i = 0; i < 4; ++i) val[4 * q + i] = 1.0f / (1.0f + __expf(-lg[i])) + rb[i]; }
            float a1 = fmaxf(val[0], val[1]), a2 = fminf(val[0], val[1]);
#pragma unroll
            for (int i = 2; i < 32; ++i) { const float v = val[i]; a2 = fmaxf(a2, fminf(a1, v)); a1 = fmaxf(a1, v); }
            const float gs = a1 + a2; int grank = 0;
#pragma unroll
            for (int k = 0; k < 8; ++k) { const float o = shi_(gs, (lane & ~7) + k); grank += (o > gs || (o == gs && k < grp)) ? 1 : 0; }
            if (grank >= 4) {
#pragma unroll
                for (int i = 0; i < 32; ++i) val[i] = -INFINITY; }
            int my_e = 0; float my_v = 0.f;
#pragma unroll 1
            for (int k = 0; k < TOPK; ++k) {
                float bv = val[0]; int bi = 0;
#pragma unroll
                for (int i = 1; i < 32; ++i) { const bool gt = val[i] > bv; bv = gt ? val[i] : bv; bi = gt ? i : bi; }
                bi += grp * 32;
#pragma unroll
                for (int o = 1; o < 8; o <<= 1) { const float ov = shx_(bv, o); const int oi = shx_(bi, o); const bool tk_ = (ov > bv) || (ov == bv && oi < bi); bv = tk_ ? ov : bv; bi = tk_ ? oi : bi; }
                const int li = (bi >> 5) == grp ? (bi & 31) : -1;
#pragma unroll
                for (int i = 0; i < 32; ++i) val[i] = (i == li) ? -INFINITY : val[i];
                if (grp == k) { my_e = bi; my_v = bv; }
            }
            const float sc = my_v - p.router_bias[my_e];
            float ssum = sc; ssum += shx_(ssum, 1); ssum += shx_(ssum, 2); ssum += shx_(ssum, 4);
            EIDX[(size_t)t * TOPK + grp] = my_e; WTS[(size_t)t * TOPK + grp] = sc / ssum * 2.5f;
            RANK[(size_t)t * TOPK + grp] = (int)__hip_atomic_fetch_add(lcnt + my_e, 1u, __ATOMIC_RELAXED, __HIP_MEMORY_SCOPE_WORKGROUP);
        }
        VM_WAIT(); LDS_WAIT(); __syncthreads();
        if (c.tid() < NEXP) { const unsigned n = lcnt[c.tid()]; lbase[c.tid()] = n ? __hip_atomic_fetch_add(CNT + halfoff + c.tid(), n, __ATOMIC_RELAXED, __HIP_MEMORY_SCOPE_AGENT) : 0u; }
        __syncthreads();
        for (int i = c.tid(); i < TPB * TOPK; i += 512) { const size_t gi = (size_t)tb0 * TOPK + i; RANK[gi] += (int)lbase[EIDX[gi]]; }
    }
}
constexpr int LDS_MISC = 131072;
constexpr int LM_BARW = LDS_MISC;
constexpr int LM_Q = LDS_MISC + 16;
constexpr int LM_OFFS = LDS_MISC + 64;
constexpr int LM_TB = LM_OFFS + 2064;
constexpr int LM_SCAN = LM_TB + 2064;
constexpr int LDS_BYTES = 147456;
static_assert(LM_SCAN + 4096 <= LDS_BYTES, "lds misc");
__device__ __forceinline__ void build_tables(const Params& p, const Ctx& c) {
    const unsigned* CNT = (const unsigned*)(p.ws + WS_CTL) + CW_CNT;
    LAS unsigned* offs = (LAS unsigned*)(c.lds + LM_OFFS); LAS unsigned* tb = (LAS unsigned*)(c.lds + LM_TB);
    LAS unsigned* s0 = (LAS unsigned*)(c.lds + LM_SCAN);
    const int t = c.tid(), lane = t & 63, w = t >> 6; const unsigned cn = __hip_atomic_load(CNT + t, __ATOMIC_RELAXED, __HIP_MEMORY_SCOPE_AGENT);
    unsigned a = cn, b = (cn + 255u) >> 8;
#pragma unroll
    for (int o = 1; o < 64; o <<= 1) { const int src = lane >= o ? lane - o : lane; const unsigned ua = shi_(a, src), ub = shi_(b, src); if (lane >= o) { a += ua; b += ub; } }
    if (lane == 63) { s0[2 * w] = a; s0[2 * w + 1] = b; }
    __syncthreads();
    unsigned pa = 0, pb = 0;
#pragma unroll
    for (int k = 0; k < 8; ++k) { const unsigned xa = s0[2 * k], xb = s0[2 * k + 1]; if (k < w) { pa += xa; pb += xb; } }
    offs[t] = pa + a - cn; tb[t] = pb + b - ((cn + 255u) >> 8);
    if (t == NSEG - 1) { offs[NSEG] = pa + a; tb[NSEG] = pb + b; }
    __syncthreads();
}
__device__ __forceinline__ void ph_scatter(const Params& p, const Ctx& c) {
    build_tables(p, c);
    const LAS unsigned* offs = (const LAS unsigned*)(c.lds + LM_OFFS);
    const int* EIDX = (const int*)(p.ws + WS_EIDX); const int* RANK = (const int*)(p.ws + WS_RANK); int* YROW = (int*)(p.ws + WS_YROW);
    const size_t gt = (size_t)c.vb * 512 + c.tid(), NGT = (size_t)c.nvb * 512;
    for (size_t i = gt; i < (size_t)NPAIR; i += NGT) { const int t = (int)(i >> 3); const int seg = (t >= HALF_T ? NEXP : 0) + EIDX[i]; YROW[offs[seg] + RANK[i]] = (int)i; }
    if (gt < 256) YROW[NPAIR + gt] = 0;
}
__device__ __forceinline__ int seg_of_tile(const LAS unsigned* tb, unsigned tile) { int lo = 0, hi = NSEG;
    while (hi - lo > 1) { const int mid = (lo + hi) >> 1; if ((unsigned)__builtin_amdgcn_readfirstlane((int)tb[mid]) <= tile) lo = mid; else hi = mid; } return lo; }
struct SchedMoE1 {
    const char* H1B; const char* WGU; const int* yrow; const LAS unsigned* offs; const LAS unsigned* tb; int G, c;
    __device__ __forceinline__ bool next(int i, pg8::Unit& u) const { const unsigned ntile = (unsigned)__builtin_amdgcn_readfirstlane((int)tb[NSEG]); const unsigned L = (unsigned)i * G + c; if (L >= 2 * ntile) return false; const unsigned tile = L >> 1; const int s = seg_of_tile(tb, tile); const unsigned row0 = offs[s] + 256u * (tile - tb[s]); const unsigned rem = offs[s + 1] - row0;
        u.pm = __builtin_amdgcn_readfirstlane((int)row0); u.pn = __builtin_amdgcn_readfirstlane((int)(L & 1)); u.a0 = __builtin_amdgcn_readfirstlane(rem < 256u ? (int)rem : 256); u.a1 = __builtin_amdgcn_readfirstlane(s & (NEXP - 1)); return true; }
    __device__ __forceinline__ const char* a_base(const pg8::Unit&) const { return H1B; }
    __device__ __forceinline__ unsigned a_off(const pg8::Unit& u, int row, int C) const { const int r = row < u.a0 ? row : u.a0 - 1; const unsigned tok = (unsigned)yrow[u.pm + r] >> 3; return (tok * DM + C) * 2u; }
    __device__ __forceinline__ size_t a_kstep() const { return 128; }
    __device__ __forceinline__ const char* b_base(const pg8::Unit& u) const { return WGU + ((size_t)u.a1 * 2 * DEXP + (size_t)u.pn * 256) * DM * 2; }
};
struct SchedMoE2 {
    const char* ACT; const char* WD; const LAS unsigned* offs; const LAS unsigned* tb; int half, G, c;
    __device__ __forceinline__ bool next(int i, pg8::Unit& u) const { const unsigned L = (unsigned)i * G + c; const unsigned t0 = (unsigned)__builtin_amdgcn_readfirstlane((int)tb[half * NEXP]), ntile = (unsigned)__builtin_amdgcn_readfirstlane((int)tb[half * NEXP + NEXP]) - t0; if (L >= 4 * ntile) return false;
        const unsigned tile = t0 + (L >> 2); const int s = seg_of_tile(tb, tile); const unsigned row0 = offs[s] + 256u * (tile - tb[s]); const unsigned rem = offs[s + 1] - row0;
        u.pm = __builtin_amdgcn_readfirstlane((int)row0); u.pn = __builtin_amdgcn_readfirstlane((int)(L & 3)); u.a0 = __builtin_amdgcn_readfirstlane(rem < 256u ? (int)rem : 256); u.a1 = __builtin_amdgcn_readfirstlane(s & (NEXP - 1)); return true; }
    __device__ __forceinline__ const char* a_base(const pg8::Unit& u) const { return ACT + (size_t)u.pm * DEXP * 2; }
    __device__ __forceinline__ unsigned a_off(const pg8::Unit&, int row, int C) const { return (unsigned)(row * DEXP + C) * 2u; }
    __device__ __forceinline__ size_t a_kstep() const { return 128; }
    __device__ __forceinline__ const char* b_base(const pg8::Unit& u) const { return WD + ((size_t)u.a1 * DM + (size_t)u.pn * 256) * DEXP * 2; }
};
struct EpiAct {
    static constexpr bool PERM = true, AFTER_DRAIN = false;
    bf16_t* O; bool pos;
    __device__ __forceinline__ void operator()(const f32x4 (&acc)[2][2][4][2], const pg8::Unit& u, int wr, int wc, int fr, int fq) const {
        const size_t rbase = pos ? (size_t)u.pm : (size_t)u.pm * 256; const int nvalid = pos ? u.a0 : 256;
#pragma unroll
        for (int ai = 0; ai < 2; ++ai)
#pragma unroll
            for (int m = 0; m < 4; ++m) { const int r = ai * 128 + wr * 64 + m * 16 + fr;
                if (r < nvalid) {
#pragma unroll
                    for (int bj = 0; bj < 2; ++bj) { const int acol = (u.pn * 256 + bj * 128 + wc * 32 + 8 * fq) >> 1; const f32x4 v0 = acc[ai][bj][m][0], v1 = acc[ai][bj][m][1];
                        u32x2 o; o.x = pk2(siluf_(v0[0]) * v0[1], siluf_(v0[2]) * v0[3]); o.y = pk2(siluf_(v1[0]) * v1[1], siluf_(v1[2]) * v1[3]);
                        *(u32x2*)(O + (rbase + r) * DEXP + acol) = o; } } }
    }
};
struct EpiY {
    static constexpr bool PERM = true, AFTER_DRAIN = false;
    bf16_t* Y; const int* yrow; int half;
    __device__ __forceinline__ void operator()(const f32x4 (&acc)[2][2][4][2], const pg8::Unit& u, int wr, int wc, int fr, int fq) const {
        int yr[2][4];
#pragma unroll
        for (int ai = 0; ai < 2; ++ai)
#pragma unroll
            for (int m = 0; m < 4; ++m) { const int r = ai * 128 + wr * 64 + m * 16 + fr; yr[ai][m] = yrow[u.pm + (r < u.a0 ? r : u.a0 - 1)]; }
#pragma unroll
        for (int ai = 0; ai < 2; ++ai)
#pragma unroll
            for (int m = 0; m < 4; ++m) { const int r = ai * 128 + wr * 64 + m * 16 + fr;
                if (r < u.a0) { const size_t y0 = (size_t)(yr[ai][m] - half * HALF_T * TOPK);
#pragma unroll
                    for (int bj = 0; bj < 2; ++bj) { const int col0 = u.pn * 256 + bj * 128 + wc * 32 + 8 * fq; const f32x4 v0 = acc[ai][bj][m][0], v1 = acc[ai][bj][m][1];
                        u32x4 w; w.x = pk2(v0[0], v0[1]); w.y = pk2(v0[2], v0[3]); w.z = pk2(v1[0], v1[1]); w.w = pk2(v1[2], v1[3]);
                        *(u32x4*)(Y + y0 * DM + col0) = w; } } }
    }
};
__device__ __forceinline__ void ph_final(const Params& p, const Ctx& c, int half) {
    const int gw = c.vb * 8 + c.wave, NGW = c.nvb * 8, lane = c.lane(); const bf16_t* Y = (const bf16_t*)(p.ws + WS_Y); const float* WTS = (const float*)(p.ws + WS_WTS);
    for (int tl = gw; tl < HALF_T; tl += NGW) { const int t = half * HALF_T + tl; float* xr = p.out + (size_t)t * DM; f32x4 a[4];
#pragma unroll
        for (int j = 0; j < 4; ++j) a[j] = *(const f32x4*)(xr + (j >> 1) * 512 + 8 * lane + (j & 1) * 4);
        const f32x4 w0 = *(const f32x4*)(WTS + (size_t)t * TOPK), w1 = *(const f32x4*)(WTS + (size_t)t * TOPK + 4);
        const float wk[8] = {w0.x, w0.y, w0.z, w0.w, w1.x, w1.y, w1.z, w1.w};
#pragma unroll
        for (int k = 0; k < TOPK; ++k) { const bf16_t* yr = Y + ((size_t)tl * TOPK + k) * DM;
#pragma unroll
            for (int j = 0; j < 2; ++j) { const u32x4 y = *(const u32x4*)(yr + j * 512 + 8 * lane);
                a[2 * j].x += wk[k] * bflo(y.x); a[2 * j].y += wk[k] * bfhi(y.x); a[2 * j].z += wk[k] * bflo(y.y); a[2 * j].w += wk[k] * bfhi(y.y);
                a[2 * j + 1].x += wk[k] * bflo(y.z); a[2 * j + 1].y += wk[k] * bfhi(y.z); a[2 * j + 1].z += wk[k] * bflo(y.w); a[2 * j + 1].w += wk[k] * bfhi(y.w); } }
        ln_row(a, p.ln2_g, p.ln2_b, lane);
#pragma unroll
        for (int j = 0; j < 4; ++j) *(f32x4*)(xr + (j >> 1) * 512 + 8 * lane + (j & 1) * 4) = a[j]; }
}
__device__ __forceinline__ void ph_inproj(const Params& p, const Ctx& c) {
    SchedPlain S{(const char*)(p.ws + WS_XB), (const char*)(p.ws + WS_WIN_T), DM, DM, NT / 256, NPROJ / 256, c.nvb, c.vb};
    EpiProj E{(bf16_t*)(p.ws + WS_PROJ), (const float*)(p.ws + WS_COS), (const float*)(p.ws + WS_SIN)};
    pg8::gemm_phase<EpiProj, SchedPlain, true>(c.lds, S, E, DM, c.wave);
}
__device__ __forceinline__ void ph_prep(const Params& p, const Ctx& c) {
    const int ncmp = c.nvb >= 128 ? 64 : 0;
    if (ncmp) {
        LAS float* lbias = (LAS float*)(c.lds + LM_SCAN);
        if (c.vb < 64) { const int t = c.tid(); if (t < 256) { const int which = c.vb & 1; float s = (which ? p.cmp_b1_v : p.cmp_b1_k)[t];
            for (int q = 0; q < 64; ++q) s += ((const float*)(p.ws + WS_BIASKV))[q * 512 + which * 256 + t]; lbias[t] = s; } }
        __syncthreads();
        SchedCmp S{(const char*)(p.ws + WS_PROJ), (const char*)(p.ws + WS_W1K_T), (const char*)(p.ws + WS_W1V_T), c.nvb, c.vb};
        EpiCmp E{lbias, (const bf16_t*)(p.ws + WS_W2K_T), (const bf16_t*)(p.ws + WS_W2V_T), (bf16_t*)(p.ws + WS_KC), (bf16_t*)(p.ws + WS_VC)};
        pg8::gemm_phase<EpiCmp, SchedCmp, false>(c.lds, S, E, 2048, c.wave);
        __syncthreads();
    }
    if (ncmp == 0) { for (int u = c.vb; u < NB * 32; u += c.nvb) gla_prep_unit(p, c, u); }
    else if (c.vb < ncmp) gla_prep_unit(p, c, c.vb);
    else for (int u = ncmp + (c.vb - ncmp); u < NB * 32; u += c.nvb - ncmp) gla_prep_unit(p, c, u);
}
constexpr int Q_GLA = NB * 4, Q_NSA = NB * 2 * 32, Q_CONV = 512;
#define QUEUE_LOOP(headword, total, BODY) for (;;) { __syncthreads(); if (c.tid() == 0) qb[0] = (int)__hip_atomic_fetch_add((headword), 1u, __ATOMIC_RELAXED, __HIP_MEMORY_SCOPE_AGENT); \
        __syncthreads(); const int idx = __builtin_amdgcn_readfirstlane(qb[0]); if (idx >= (total)) break; BODY; }
__device__ __forceinline__ void ph_mix(const Params& p, const Ctx& c) {
    unsigned* head = (unsigned*)(p.ws + WS_CTL) + CW_QHEAD;
    LAS int* qb = (LAS int*)(c.lds + LM_Q);
    QUEUE_LOOP(head, Q_GLA, gla_unit(p, c, idx));
    QUEUE_LOOP(head + 64, Q_NSA, nsa_unit(p, c, idx));
#if PROBE_ON == 2
}
__device__ __forceinline__ void ph_mix2(const Params& p, const Ctx& c) {
    unsigned* head = (unsigned*)(p.ws + WS_CTL) + CW_QHEAD;
    LAS int* qb = (LAS int*)(c.lds + LM_Q);
#endif
    QUEUE_LOOP(head + 128, Q_CONV, conv_wgu(p, c, idx * 128 + c.wave, 8, (idx + 1) * 128));
}
__device__ __forceinline__ void ph_outproj(const Params& p, const Ctx& c) {
    SchedPlain S{(const char*)(p.ws + WS_MIX), (const char*)(p.ws + WS_WO_T), DM, DM, NT / 256, DM / 256, c.nvb, c.vb};
    EpiAxpyF32 E{p.x, p.out, DM, DN_ALPHA};
    pg8::gemm_phase<EpiAxpyF32, SchedPlain, true>(c.lds, S, E, DM, c.wave);
}
__device__ __forceinline__ void ph_router(const Params& p, const Ctx& c) {
    SchedPlain S{(const char*)(p.ws + WS_H1B), (const char*)(p.ws + WS_WR_T), DM, DM, NT / 256, 1, c.nvb, c.vb};
    EpiAxpyF32 E{nullptr, (float*)(p.ws + WS_LOGITS), NEXP, 0.f};
    pg8::gemm_phase<EpiAxpyF32, SchedPlain, true>(c.lds, S, E, DM, c.wave);
}
__device__ __forceinline__ int xcd_vb(const Ctx& c) { return (c.nvb % 8 == 0) ? (c.vb % 8) * (c.nvb / 8) + c.vb / 8 : c.vb; }
__device__ __forceinline__ void ph_gemm1(const Params& p, const Ctx& c) {
    build_tables(p, c);
    { SchedMoE1 S{(const char*)(p.ws + WS_H1B), (const char*)(p.ws + WS_WGU_T), (const int*)(p.ws + WS_YROW), (const LAS unsigned*)(c.lds + LM_OFFS), (const LAS unsigned*)(c.lds + LM_TB), c.nvb, xcd_vb(c)};
      EpiAct E{(bf16_t*)(p.ws + WS_ACT), true};
      pg8::gemm_phase<EpiAct, SchedMoE1, true>(c.lds, S, E, DM, c.wave); }
    __syncthreads();
    { SchedPlain S{(const char*)(p.ws + WS_H1B), (const char*)(p.ws + WS_WSGU_T), DM, DM, NT / 256, 2, c.nvb, c.vb};
      EpiAct E{(bf16_t*)(p.ws + WS_ACTS), false};
      pg8::gemm_phase<EpiAct, SchedPlain, true>(c.lds, S, E, DM, c.wave); }
}
__device__ __forceinline__ void ph_gemm2(const Params& p, const Ctx& c, int half) {
    build_tables(p, c);
    SchedMoE2 S{(const char*)(p.ws + WS_ACT), (const char*)(p.ws + WS_WD_T), (const LAS unsigned*)(c.lds + LM_OFFS), (const LAS unsigned*)(c.lds + LM_TB), half, c.nvb, xcd_vb(c)};
    EpiY E{(bf16_t*)(p.ws + WS_Y), (const int*)(p.ws + WS_YROW), half};
    pg8::gemm_phase<EpiY, SchedMoE2, true>(c.lds, S, E, DEXP, c.wave);
}
__device__ __forceinline__ void ph_sh2(const Params& p, const Ctx& c) {
    SchedPlain S{(const char*)(p.ws + WS_ACTS), (const char*)(p.ws + WS_WSD_T), DEXP, DEXP, NT / 256, DM / 256, c.nvb, c.vb};
    EpiAxpyF32 E{p.out, p.out, DM, DN_ALPHA};
    pg8::gemm_phase<EpiAxpyF32, SchedPlain, true>(c.lds, S, E, DEXP, c.wave);
}
constexpr int N_PHASES = 14;
template <int PH> __device__ __forceinline__ void run_phase(const Params& p, const Ctx& c) {
    if constexpr (PH == 0) ph_prologue(p, c);
    if constexpr (PH == 1) ph_inproj(p, c);
    if constexpr (PH == 2) ph_prep(p, c);
    if constexpr (PH == 3) ph_mix(p, c);
    if constexpr (PH == 4) ph_outproj(p, c);
    if constexpr (PH == 5) { ph_ln1(p, c); conv_wd(p, c, c.vb * 8 + c.wave, c.nvb * 8, NEXP * 128); }
    if constexpr (PH == 6) ph_router(p, c);
    if constexpr (PH == 7) ph_route(p, c);
    if constexpr (PH == 8) ph_scatter(p, c);
    if constexpr (PH == 9) ph_gemm1(p, c);
    if constexpr (PH == 10) { ph_gemm2(p, c, 0); __syncthreads(); ph_sh2(p, c); }
    if constexpr (PH == 11) ph_final(p, c, 0);
    if constexpr (PH == 12) ph_gemm2(p, c, 1);
    if constexpr (PH == 13) ph_final(p, c, 1);
}
#ifndef MK_MULTI
#define MK_MULTI 0
#endif
#if MK_MULTI
template <int PH> __global__ void __launch_bounds__(512, 2) k_phase(Params p) {
    extern __shared__ __attribute__((aligned(16))) unsigned char lds_raw[];
    Ctx c; c.lds = (LAS unsigned char*)lds_raw; c.wave = __builtin_amdgcn_readfirstlane((int)threadIdx.x >> 6);
    c.vb = blockIdx.x; c.nvb = gridDim.x;
    run_phase<PH>(p, c);
}
#endif
__global__ void __launch_bounds__(512, 2) k_mega(Params p) {
    extern __shared__ __attribute__((aligned(16))) unsigned char lds_raw[];
    Ctx c; c.lds = (LAS unsigned char*)lds_raw; c.wave = __builtin_amdgcn_readfirstlane((int)threadIdx.x >> 6);
    c.vb = blockIdx.x; c.nvb = gridDim.x;
    if (c.tid() < 4) ((LAS unsigned*)(c.lds + LM_BARW))[c.tid()] = 0u;
    __syncthreads();
    const XcdBarrier bar = xcd_barrier_post((unsigned*)(p.ws + WS_CTL) + CW_BAR, (volatile LAS unsigned*)(c.lds + LM_BARW), c.tid() == 0);
#if PROBE_ON
    unsigned long long ts_[N_PHASES + 1]; ts_[0] = __builtin_amdgcn_s_memrealtime();
#define STAMP(k) ts_[k] = __builtin_amdgcn_s_memrealtime()
#else
#define STAMP(k)
#endif
    run_phase<0>(p, c); xcd_barrier(bar, c.tid() == 0); STAMP(1);
    run_phase<1>(p, c); xcd_barrier(bar, c.tid() == 0); STAMP(2);
    run_phase<2>(p, c); xcd_barrier(bar, c.tid() == 0); STAMP(3);
    run_phase<3>(p, c); xcd_barrier(bar, c.tid() == 0); STAMP(4);
#if PROBE_ON == 2
    ph_mix2(p, c); xcd_barrier(bar, c.tid() == 0);
#endif
    run_phase<4>(p, c); xcd_barrier(bar, c.tid() == 0); STAMP(5);
    run_phase<5>(p, c); xcd_barrier(bar, c.tid() == 0); STAMP(6);
    run_phase<6>(p, c); xcd_barrier(bar, c.tid() == 0); STAMP(7);
    run_phase<7>(p, c); xcd_barrier(bar, c.tid() == 0); STAMP(8);
    run_phase<8>(p, c); xcd_barrier(bar, c.tid() == 0); STAMP(9);
    run_phase<9>(p, c); xcd_barrier(bar, c.tid() == 0); STAMP(10);
    run_phase<10>(p, c); xcd_barrier(bar, c.tid() == 0); STAMP(11);
    run_phase<11>(p, c); xcd_barrier(bar, c.tid() == 0); STAMP(12);
    run_phase<12>(p, c); xcd_barrier(bar, c.tid() == 0); STAMP(13);
    run_phase<13>(p, c); STAMP(14);
#if PROBE_ON
    if (blockIdx.x == 0) { __syncthreads();
        if (c.tid() == 0) { const unsigned long long tot = ts_[N_PHASES] - ts_[0], da = ts_[PROBE_A + 1] - ts_[PROBE_A], dt = ts_[PROBE_T + 1] - ts_[PROBE_T];
            const unsigned long long t0 = __builtin_amdgcn_s_memrealtime(); while (__builtin_amdgcn_s_memrealtime() - t0 < dt) __builtin_amdgcn_s_sleep(8);
            VM_WAIT(); p.out[0] += 1.0f + (float)((100ull * da) / (tot ? tot : 1ull)); } }
#endif
}
#ifndef MK_MULTI
#define MK_MULTI 0
#endif
#if MK_MULTI
template <int PH> static void launch_phase(const Params& p, int grid, hipStream_t stream) {
    static bool attr = false;
    if (!attr) { (void)hipFuncSetAttribute((const void*)k_phase<PH>, hipFuncAttributeMaxDynamicSharedMemorySize, LDS_BYTES); attr = true; }
    hipLaunchKernelGGL(k_phase<PH>, dim3(grid), dim3(512), LDS_BYTES, stream, p);
}
#endif
extern "C" void kernel_launch(void* const* d_in, const int* in_sizes, int n_in, void* d_out, int out_size, void* d_ws, size_t ws_size, hipStream_t stream) {
    if (n_in != 27 || ws_size < WS_END) { fprintf(stderr, "kernel_launch: unexpected inputs (n_in %d, ws %zu)\n", n_in, ws_size); return; }
    Params p{};
    p.x = (const float*)d_in[0]; p.positions = (const int*)d_in[1]; p.w_in = (const float*)d_in[2]; p.w_alpha2 = (const float*)d_in[3]; p.b_alpha = (const float*)d_in[4]; p.gla_norm_g = (const float*)d_in[5];
    p.cmp_pos_k = (const float*)d_in[6]; p.cmp_w1_k = (const float*)d_in[7]; p.cmp_b1_k = (const float*)d_in[8]; p.cmp_w2_k = (const float*)d_in[9];
    p.cmp_pos_v = (const float*)d_in[10]; p.cmp_w1_v = (const float*)d_in[11]; p.cmp_b1_v = (const float*)d_in[12]; p.cmp_w2_v = (const float*)d_in[13];
    p.w_out = (const float*)d_in[14]; p.ln1_g = (const float*)d_in[15]; p.ln1_b = (const float*)d_in[16]; p.w_router = (const float*)d_in[17]; p.router_bias = (const float*)d_in[18];
    p.w_exp_gate = (const float*)d_in[19]; p.w_exp_up = (const float*)d_in[20]; p.w_exp_down = (const float*)d_in[21]; p.w_sh_gate = (const float*)d_in[22]; p.w_sh_up = (const float*)d_in[23]; p.w_sh_down = (const float*)d_in[24];
    p.ln2_g = (const float*)d_in[25]; p.ln2_b = (const float*)d_in[26];
    p.out = (float*)d_out; p.ws = (unsigned char*)d_ws;
    (void)hipMemsetAsync((char*)d_ws + WS_CTL, 0, CTL_ZERO_BYTES, stream);
#if MK_MULTI
    const int grid = 256;
    launch_phase<0>(p, grid, stream); launch_phase<1>(p, grid, stream); launch_phase<2>(p, grid, stream); launch_phase<3>(p, grid, stream);
    launch_phase<4>(p, grid, stream); launch_phase<5>(p, grid, stream); launch_phase<6>(p, grid, stream); launch_phase<7>(p, grid, stream);
    launch_phase<8>(p, grid, stream); launch_phase<9>(p, grid, stream); launch_phase<10>(p, grid, stream); launch_phase<11>(p, grid, stream);
    launch_phase<12>(p, grid, stream); launch_phase<13>(p, grid, stream);
#else
    static int grid = 0;
    if (grid == 0) { int dev = 0, cus = 0;
        if (hipGetDevice(&dev) != hipSuccess || hipDeviceGetAttribute(&cus, hipDeviceAttributeMultiprocessorCount, dev) != hipSuccess || cus <= 0) cus = 256;
        (void)hipFuncSetAttribute((const void*)k_mega, hipFuncAttributeMaxDynamicSharedMemorySize, LDS_BYTES);
        grid = cus; }
    hipLaunchKernelGGL(k_mega, dim3(grid), dim3(512), LDS_BYTES, stream, p);
#endif
}
```

```cpp
#include <hip/hip_runtime.h>
#include <cstdint>
#include <cstdio>
#include <cmath>

#ifndef PROBE_ON
#define PROBE_ON 0
#define PROBE_T 3
#define PROBE_A 9
#endif
#define LAS __attribute__((address_space(3)))
#define GAS __attribute__((address_space(1)))
typedef unsigned short bf16_t;
typedef short bf16x8 __attribute__((ext_vector_type(8)));
typedef short s16x4 __attribute__((ext_vector_type(4)));
typedef float f32x2 __attribute__((ext_vector_type(2)));
typedef float f32x4 __attribute__((ext_vector_type(4)));
typedef float f32x16 __attribute__((ext_vector_type(16)));
typedef unsigned u32x2 __attribute__((ext_vector_type(2)));
typedef unsigned u32x4 __attribute__((ext_vector_type(4)));

constexpr int NB = 32, SEQ = 2048, DM = 1024, NT = NB * SEQ;
constexpr int NPROJ = 3072;
constexpr int D_IN = 2856;
constexpr int PC_GQ = 0, PC_GK = 256, PC_GV = 512, PC_GR = 1024, PC_NQ = 1536, PC_NKC = 2048, PC_NKS = 2176, PC_NKW = 2304,
              PC_NVC = 2432, PC_NVS = 2560, PC_NVW = 2688, PC_GA = 2816, PC_NG = 2832;
constexpr int OC_GQ = 0, OC_GK = 256, OC_GV = 512, OC_GA = 1024, OC_GR = 1040, OC_NQ = 1552, OC_NKC = 2064, OC_NVC = 2192,
              OC_NKS = 2320, OC_NVS = 2448, OC_NKW = 2576, OC_NVW = 2704, OC_NG = 2832;
constexpr int NEXP = 256, TOPK = 8, DEXP = 256, NPAIR = NT * TOPK;
constexpr int NSEG = NEXP;
constexpr float Y_SCALE = 8.0f;
constexpr float DN_ALPHA = 1.189207115002721f;
constexpr float LN_EPS = 1e-5f;
constexpr float LOG2E = 1.4426950408889634f;

constexpr size_t MiB = 1u << 20;
constexpr size_t WS_CTL = 0, CTL_ZERO_BYTES = 1 * MiB;
constexpr size_t WS_BIASKV = 1 * MiB + 131072;
constexpr size_t WS_W2K_T = 1 * MiB, WS_W2V_T = 1 * MiB + 65536;
constexpr size_t WS_COS = 2 * MiB, WS_SIN = 10 * MiB;
constexpr size_t WS_WIN_T = 18 * MiB;
constexpr size_t WS_WO_T = 24 * MiB;
constexpr size_t WS_WR_T = 26 * MiB;
constexpr size_t WS_WSGU_T = 26 * MiB + 512 * 1024;
constexpr size_t WS_WSD_T = 27 * MiB + 512 * 1024;
constexpr size_t WS_W1K_T = 28 * MiB;
constexpr size_t WS_W1V_T = 29 * MiB;
constexpr size_t WS_KC = 30 * MiB, WS_VC = 31 * MiB;
constexpr size_t WS_EIDX = 32 * MiB;
constexpr size_t WS_WTS = 34 * MiB;
constexpr size_t WS_RANK = 36 * MiB;
constexpr size_t WS_YROW = 38 * MiB;
constexpr size_t WS_EBL = 41 * MiB;
constexpr size_t WS_PROJ = 48 * MiB;
constexpr size_t WS_LOGITS = 48 * MiB;
constexpr size_t WS_ACT = 48 * MiB;
constexpr size_t WS_WD_T = 306 * MiB;
constexpr size_t WS_WGU_T = 434 * MiB;
constexpr size_t WS_Y = 434 * MiB;
constexpr size_t WS_QB = 690 * MiB, WS_KB = 722 * MiB, WS_KL = 754 * MiB;
constexpr size_t WS_H1B = 690 * MiB;
constexpr size_t WS_XB = 818 * MiB;
constexpr size_t WS_MIX = 818 * MiB;
constexpr size_t WS_ACTS = 946 * MiB;
constexpr size_t WS_END = 978 * MiB;
static_assert(WS_PROJ + (size_t)NT * NPROJ * 2 <= WS_WGU_T, "proj");
static_assert(WS_ACT + (size_t)(NPAIR + 256) * 256 * 2 <= WS_WD_T, "act");

constexpr int CW_FLAG = 0;
constexpr int CW_BAR = 4096;
constexpr int CW_CNT = 16384;
constexpr int CW_QHEAD = 20480;

__device__ __forceinline__ unsigned f2bf(float f) { unsigned u = __builtin_bit_cast(unsigned, f); return (u + 0x7fffu + ((u >> 16) & 1u)) >> 16; }
typedef __bf16 bf16x2_t __attribute__((ext_vector_type(2)));
__device__ __forceinline__ unsigned pk2(float lo, float hi) { f32x2 v = {lo, hi}; bf16x2_t b = __builtin_convertvector(v, bf16x2_t); return __builtin_bit_cast(unsigned, b); }
__device__ __forceinline__ float bf2f(unsigned short b) { return __builtin_bit_cast(float, (unsigned)b << 16); }
__device__ __forceinline__ float bflo(unsigned w) { return __builtin_bit_cast(float, w << 16); }
__device__ __forceinline__ float bfhi(unsigned w) { return __builtin_bit_cast(float, w & 0xffff0000u); }
__device__ __forceinline__ int hw_lane_() { int x = (int)__builtin_amdgcn_mbcnt_hi(~0u, __builtin_amdgcn_mbcnt_lo(~0u, 0u)); asm volatile("" : "+v"(x)); return x; }
__device__ __forceinline__ int shi_(int v, int src) { return __builtin_amdgcn_ds_bpermute(src << 2, v); }
__device__ __forceinline__ float shi_(float v, int src) { return __builtin_bit_cast(float, __builtin_amdgcn_ds_bpermute(src << 2, __builtin_bit_cast(int, v))); }
__device__ __forceinline__ unsigned shi_(unsigned v, int src) { return (unsigned)__builtin_amdgcn_ds_bpermute(src << 2, (int)v); }
template <class T> __device__ __forceinline__ T shx_(T v, int mask) { return shi_(v, hw_lane_() ^ mask); }
__device__ __forceinline__ float wave_sum(float v) {
    const int l = hw_lane_();
#pragma unroll
    for (int o = 1; o < 64; o <<= 1) v += shi_(v, l ^ o);
    return v;
}
__device__ __forceinline__ float sigmoidf_(float x) { return 1.0f / (1.0f + __expf(-x)); }
__device__ __forceinline__ float siluf_(float x) { return x / (1.0f + __expf(-x)); }
#define LDS_WAIT() asm volatile("s_waitcnt lgkmcnt(0)" ::: "memory")
#define VM_WAIT() asm volatile("s_waitcnt vmcnt(0)" ::: "memory")
#define XB_TMO      128
#define XB_XCNT(j)  (256  + 64 * (j))
#define XB_XSUB(j)  (1280 + 64 * (j))
#define XB_XGEN(j)  (2304 + 64 * (j))
#define XB_TOP      3328
#define XB_TOPGEN   3392
#define XCD_BAR_WORDS 3456
#define XB_SPIN_CAP (1u << 18)
__device__ __forceinline__ unsigned xb_ld(unsigned* p)              { return __hip_atomic_load(p, __ATOMIC_RELAXED, __HIP_MEMORY_SCOPE_AGENT); }
__device__ __forceinline__ unsigned xb_add(unsigned* p, unsigned v) { return __hip_atomic_fetch_add(p, v, __ATOMIC_RELAXED, __HIP_MEMORY_SCOPE_AGENT); }
__device__ __forceinline__ unsigned xb_xcc_id() { return (unsigned)__builtin_amdgcn_s_getreg((3 << 11) | 20) & 0xFu; }
#define XB_SPIN(cond, bar) do { unsigned _sp = 0; while (cond) { __builtin_amdgcn_s_sleep(1); \
    if ((++_sp & 255u) == 0u) { if (xb_ld(&(bar)[XB_TMO])) break; if (_sp > XB_SPIN_CAP) { atomicAdd(&(bar)[XB_TMO], 1u); break; } } } } while (0)
struct XcdBarrier { unsigned* bar; unsigned x; volatile LAS unsigned* st; };
__device__ __forceinline__ XcdBarrier xcd_barrier_post(unsigned* bar, volatile LAS unsigned* st, bool is_t0) {
    XcdBarrier b; b.bar = bar; b.x = xb_xcc_id(); b.st = st;
    if (is_t0) (void)xb_add(&bar[XB_XCNT(b.x)], 1u);
    return b;
}
__device__ __forceinline__ void xcd_barrier_complete(unsigned* bar, unsigned x, unsigned& nloc, unsigned& nx) {
    const unsigned G = gridDim.x * gridDim.y * gridDim.z;
    unsigned sum, cnt, mine, sp = 0u;
    for (;;) {
        sum = 0u; cnt = 0u; mine = 0u;
#pragma unroll
        for (unsigned j = 0; j < 16; ++j) { const unsigned c = xb_ld(&bar[XB_XCNT(j)]); sum += c; cnt += (c > 0u) ? 1u : 0u; mine = (j == x) ? c : mine; }
        if (sum == G) break;
        __builtin_amdgcn_s_sleep(1);
        if ((++sp & 255u) == 0u) { if (xb_ld(&bar[XB_TMO])) break; if (sp > XB_SPIN_CAP) { atomicAdd(&bar[XB_TMO], 1u); break; } }
    }
    nloc = mine > 0u ? mine : 1u; nx = cnt > 0u ? cnt : 1u;
}
__device__ __forceinline__ void xcd_barrier(const XcdBarrier& b, bool is_t0) {
    asm volatile("s_waitcnt vmcnt(0)" ::: "memory");
    __syncthreads();
    if (is_t0) {
        unsigned* bar = b.bar;
        __builtin_amdgcn_s_waitcnt(0);
        unsigned nloc = b.st[0], nx = b.st[1];
        if (nloc == 0u) { xcd_barrier_complete(bar, b.x, nloc, nx); b.st[0] = nloc; b.st[1] = nx; }
        const unsigned old = xb_add(&bar[XB_XSUB(b.x)], 1u);
        const unsigned gen = old / nloc;
        if (old + 1u == (gen + 1u) * nloc) {
            __builtin_amdgcn_fence(__ATOMIC_RELEASE, "agent");
            asm volatile("s_waitcnt vmcnt(0)" ::: "memory");
            const unsigned og = xb_add(&bar[XB_TOP], 1u);
            const unsigned tg = og / nx;
            if (og + 1u == (tg + 1u) * nx) xb_add(&bar[XB_TOPGEN], 1u);
            else XB_SPIN(xb_ld(&bar[XB_TOPGEN]) == tg, bar);
            __builtin_amdgcn_fence(__ATOMIC_ACQUIRE, "agent");
            xb_add(&bar[XB_XGEN(b.x)], 1u);
            asm volatile("s_waitcnt vmcnt(0)" ::: "memory");
        } else {
            XB_SPIN(xb_ld(&bar[XB_XGEN(b.x)]) == gen, bar);
            __builtin_amdgcn_fence(__ATOMIC_ACQUIRE, "agent");
            asm volatile("s_waitcnt vmcnt(0)" ::: "memory");
        }
    }
    __syncthreads();
}
namespace pg8 {
constexpr int BM = 256, BK = 64, HALF = 128, HTB = HALF * BK * 2, STAGE_BYTES = 8 * HTB;
__host__ __device__ __forceinline__ int lds_byte(int r, int c) { const int st = (r >> 4) * 2 + (c >> 5), rr = r & 15, cc = c & 31, ob = rr * 64 + cc * 2; return st * 1024 + (ob ^ (((ob >> 9) & 1) << 5)); }
__host__ __device__ __forceinline__ void stage_rc(int b, int& R, int& C) { const int st = b / 1024, sb = b % 1024, swz = sb ^ (((sb >> 9) & 1) << 5); R = (st >> 1) * 16 + swz / 64; C = (st & 1) * 32 + (swz % 64) / 2; }
__host__ __device__ __forceinline__ int perm32(int rho) { const int n = rho >> 4, i = rho & 15; return 8 * (i >> 2) + 4 * n + (i & 3); }
struct Unit { int pm, pn, a0, a1; };
template <class Epi, class Sched, bool ALIGN_EPI>
__device__ __forceinline__ void gemm_phase(LAS unsigned char* lds, const Sched& S, const Epi& E, const int K, const int wave_id) {
    int tid_ = wave_id * 64 + (int)__builtin_amdgcn_mbcnt_hi(~0u, __builtin_amdgcn_mbcnt_lo(~0u, 0u)); asm volatile("" : "+v"(tid_));
    const int tid = tid_, wid = __builtin_amdgcn_readfirstlane(tid >> 6), lane = tid & 63, wr = wid >> 2, wc = wid & 3, fr = lane & 15, fq = lane >> 4;
    const int nt = K / BK;
    unsigned voffB[2];
#pragma unroll
    for (int i = 0; i < 2; ++i) { int R, C; stage_rc(tid * 16 + i * 8192, R, C); const int Rb = Epi::PERM ? ((R & ~31) + perm32(R & 31)) : R;
        voffB[i] = (unsigned)(Rb * K + C) * 2u; }
#define PG8_AOFF(dst, unit) do { int t2_ = tid; asm volatile("" : "+v"(t2_)); _Pragma("unroll") for (int i_ = 0; i_ < 2; ++i_) { int R_, C_; stage_rc(t2_ * 16 + i_ * 8192, R_, C_); \
        dst[0][i_] = S.a_off(unit, R_, C_); dst[1][i_] = S.a_off(unit, HALF + R_, C_); } } while (0)
    const size_t kstepB = (size_t)(BK * 2), hstepB = (size_t)HALF * K * 2, kstepA = S.a_kstep();
    const unsigned ldsw = (unsigned)wid * 1024u;
    const int aoff = lds_byte(wr * 64 + fr, fq * 8), boff = lds_byte(wc * 32 + fr, fq * 8);
#define PG8_SA(b, h) (((b) * 2 + (h)) * HTB)
#define PG8_SB(b, h) ((4 + (b) * 2 + (h)) * HTB)
#define PG8_STAGE(bufoff, gbase, voff) do { _Pragma("unroll") for (int _i = 0; _i < 2; ++_i) \
        __builtin_amdgcn_global_load_lds((const unsigned*)((const char*)(gbase) + (voff)[_i]), (LAS unsigned*)(lds + (bufoff) + ldsw + _i * 8192), 16, 0, 0); } while (0)
#define PG8_LDA(dst, b, h) do { _Pragma("unroll") for (int m = 0; m < 4; ++m) _Pragma("unroll") for (int k = 0; k < 2; ++k) dst[m][k] = *(const LAS bf16x8*)(lds + PG8_SA(b, h) + aoff + m * 2048 + k * 1024); } while (0)
#define PG8_LDB(dst, b, h) do { _Pragma("unroll") for (int n = 0; n < 2; ++n) _Pragma("unroll") for (int k = 0; k < 2; ++k) dst[n][k] = *(const LAS bf16x8*)(lds + PG8_SB(b, h) + boff + n * 2048 + k * 1024); } while (0)
#define PG8_MMA(ai, bj, At, Bt) do { __builtin_amdgcn_s_setprio(1); _Pragma("unroll") for (int m = 0; m < 4; ++m) _Pragma("unroll") for (int n = 0; n < 2; ++n) _Pragma("unroll") for (int k = 0; k < 2; ++k) \
        acc[ai][bj][m][n] = __builtin_amdgcn_mfma_f32_16x16x32_bf16(Bt[n][k], At[m][k], acc[ai][bj][m][n], 0, 0, 0); __builtin_amdgcn_s_setprio(0); } while (0)
#define PG8_WAIT_V(n) asm volatile("s_waitcnt vmcnt(" #n ")" ::: "memory")
#define PG8_WAIT_L(n) asm volatile("s_waitcnt lgkmcnt(" #n ")" ::: "memory")
#define PG8_BAR __builtin_amdgcn_s_barrier()
#define PG8_SCHED __builtin_amdgcn_sched_barrier(0)
    Unit cur, nxt; int ui = 0;
    if (!S.next(0, cur)) return;
    f32x4 acc[2][2][4][2];
#pragma unroll
    for (int a = 0; a < 2; ++a)
#pragma unroll
        for (int b = 0; b < 2; ++b)
#pragma unroll
            for (int m = 0; m < 4; ++m)
#pragma unroll
                for (int n = 0; n < 2; ++n) acc[a][b][m][n] = (f32x4){0.f, 0.f, 0.f, 0.f};
    bf16x8 At[4][2], B0[2][2], B1[2][2];
    unsigned vC[2][2], vN[2][2];
    PG8_AOFF(vC, cur);
    const char* cA = S.a_base(cur); const char* cB = S.b_base(cur);
    PG8_STAGE(PG8_SB(0, 0), cB, voffB); PG8_STAGE(PG8_SB(0, 1), cB + hstepB, voffB); PG8_STAGE(PG8_SA(0, 0), cA, vC[0]); PG8_STAGE(PG8_SA(0, 1), cA, vC[1]);
    if (wr == 1) PG8_BAR;
    PG8_WAIT_V(2); PG8_BAR;
    PG8_STAGE(PG8_SB(1, 0), cB + kstepB, voffB); PG8_STAGE(PG8_SA(1, 0), cA + kstepA, vC[0]); PG8_STAGE(PG8_SB(1, 1), cB + hstepB + kstepB, voffB);
    PG8_WAIT_V(6); PG8_BAR;
    for (;;) {
        const bool has_next = S.next(ui + 1, nxt);
        const char* nA = has_next ? S.a_base(nxt) : cA; const char* nB = has_next ? S.b_base(nxt) : cB;
        if (has_next) { PG8_AOFF(vN, nxt); } else {
#pragma unroll
            for (int h = 0; h < 2; ++h)
#pragma unroll
                for (int i = 0; i < 2; ++i) vN[h][i] = vC[h][i]; }
#pragma nounroll
        for (int t = 0; t < nt; t += 2) {
            const bool last = (t == nt - 2);
            const char* a1 = cA + (size_t)(t + 1) * kstepA;
            const char* a2 = last ? nA : cA + (size_t)(t + 2) * kstepA; const char* b2 = last ? nB : cB + (size_t)(t + 2) * kstepB;
            const char* a3 = a2 + kstepA; const char* b3 = b2 + kstepB;
            unsigned v2[2][2];
#pragma unroll
            for (int h = 0; h < 2; ++h)
#pragma unroll
                for (int i = 0; i < 2; ++i) v2[h][i] = last ? vN[h][i] : vC[h][i];
            PG8_LDB(B0, 0, 0); PG8_LDB(B1, 0, 1); PG8_SCHED; PG8_LDA(At, 0, 0); PG8_STAGE(PG8_SA(1, 1), a1, vC[1]);
            PG8_WAIT_V(8); PG8_WAIT_L(0); PG8_BAR; PG8_MMA(0, 0, At, B0); PG8_MMA(0, 1, At, B1); PG8_BAR; PG8_SCHED;
            PG8_LDA(At, 0, 1); PG8_STAGE(PG8_SB(0, 0), b2, voffB); PG8_STAGE(PG8_SB(0, 1), b2 + hstepB, voffB); PG8_STAGE(PG8_SA(0, 0), a2, v2[0]);
            PG8_WAIT_V(8); PG8_WAIT_L(0); PG8_BAR; PG8_MMA(1, 0, At, B0); PG8_MMA(1, 1, At, B1); PG8_BAR; PG8_SCHED;
            PG8_LDB(B0, 1, 0); PG8_LDB(B1, 1, 1); PG8_SCHED; PG8_LDA(At, 1, 0); PG8_STAGE(PG8_SA(0, 1), a2, v2[1]);
            PG8_WAIT_V(8); PG8_WAIT_L(0); PG8_BAR; PG8_MMA(0, 0, At, B0); PG8_MMA(0, 1, At, B1); PG8_BAR; PG8_SCHED;
            PG8_LDA(At, 1, 1); PG8_STAGE(PG8_SB(1, 0), b3, voffB); PG8_STAGE(PG8_SB(1, 1), b3 + hstepB, voffB); PG8_STAGE(PG8_SA(1, 0), a3, v2[0]);
            PG8_WAIT_V(8); PG8_WAIT_L(0); PG8_BAR; PG8_MMA(1, 0, At, B0); PG8_MMA(1, 1, At, B1); PG8_BAR; PG8_SCHED;
        }
        if constexpr (ALIGN_EPI) { if (wr == 0) PG8_BAR; }
        if constexpr (!Epi::AFTER_DRAIN) { E(acc, cur, wr, wc, fr, fq); }
        if (!has_next) break;
#pragma unroll
        for (int a = 0; a < 2; ++a)
#pragma unroll
            for (int b = 0; b < 2; ++b)
#pragma unroll
                for (int m = 0; m < 4; ++m)
#pragma unroll
                    for (int n = 0; n < 2; ++n) acc[a][b][m][n] = (f32x4){0.f, 0.f, 0.f, 0.f};
        cur = nxt; cA = nA; cB = nB; ++ui;
#pragma unroll
        for (int h = 0; h < 2; ++h)
#pragma unroll
            for (int i = 0; i < 2; ++i) vC[h][i] = vN[h][i];
        if constexpr (ALIGN_EPI) { if (wr == 1) PG8_BAR; }
    }
    PG8_WAIT_V(0);
    if constexpr (!ALIGN_EPI) { if (wr == 0) PG8_BAR; }
    PG8_BAR;
    if constexpr (Epi::AFTER_DRAIN) { E.fused(acc, cur, wr, wc, fr, fq, lds, wid, lane); }
#undef PG8_AOFF
#undef PG8_SA
#undef PG8_SB
#undef PG8_STAGE
#undef PG8_LDA
#undef PG8_LDB
#undef PG8_MMA
#undef PG8_WAIT_V
#undef PG8_WAIT_L
#undef PG8_BAR
#undef PG8_SCHED
}
}
struct Params {
    const float* x; const int* positions; const float* w_in; const float* w_alpha2; const float* b_alpha; const float* gla_norm_g;
    const float* cmp_pos_k; const float* cmp_w1_k; const float* cmp_b1_k; const float* cmp_w2_k;
    const float* cmp_pos_v; const float* cmp_w1_v; const float* cmp_b1_v; const float* cmp_w2_v;
    const float* w_out; const float* ln1_g; const float* ln1_b; const float* w_router; const float* router_bias;
    const float* w_exp_gate; const float* w_exp_up; const float* w_exp_down; const float* w_sh_gate; const float* w_sh_up; const float* w_sh_down;
    const float* ln2_g; const float* ln2_b;
    float* out; unsigned char* ws;
};
#define HW_LANE() hw_lane_()
struct Ctx { int wave, vb, nvb; LAS unsigned char* lds;
    __device__ __forceinline__ int lane() const { return HW_LANE(); }
    __device__ __forceinline__ int tid() const { return wave * 64 + HW_LANE(); } };

__device__ __forceinline__ int rope_od(int cc) { return (cc >> 1) + 32 * (cc & 1); }
__device__ __forceinline__ int proj_src(int pc, float& sc) {
    sc = 1.f;
    if (pc < 256) { sc = 0.125f; return OC_GQ + pc; }
    if (pc < 512) return OC_GK + (pc - 256);
    if (pc < 1024) return OC_GV + (pc - 512);
    if (pc < 1536) return OC_GR + (pc - 1024);
    if (pc < 2048) { const int c = pc - 1536; sc = 0.125f * LOG2E; return OC_NQ + (c & ~63) + rope_od(c & 63); }
    if (pc < 2176) { const int c = pc - 2048; return OC_NKC + (c & ~63) + rope_od(c & 63); }
    if (pc < 2304) { const int c = pc - 2176; return OC_NKS + (c & ~63) + rope_od(c & 63); }
    if (pc < 2432) { const int c = pc - 2304; return OC_NKW + (c & ~63) + rope_od(c & 63); }
    if (pc < 2560) return OC_NVC + (pc - 2432);
    if (pc < 2688) return OC_NVS + (pc - 2560);
    if (pc < 2816) return OC_NVW + (pc - 2688);
    if (pc < 2832) return OC_GA + (pc - 2816);
    if (pc < 2856) return OC_NG + (pc - 2832);
    return -1;
}
struct SrcWin { const float* W; __device__ __forceinline__ float operator()(int k, int n) const { float sc; const int oc = proj_src(n, sc); return oc < 0 ? 0.f : W[(size_t)k * D_IN + oc] * sc; } };
struct SrcPlain { const float* W; int ld; __device__ __forceinline__ float operator()(int k, int n) const { return W[(size_t)k * ld + n]; } };
struct SrcGU { const float* G; const float* U; __device__ __forceinline__ float operator()(int k, int n) const { return (n & 1) ? U[(size_t)k * DEXP + (n >> 1)] : G[(size_t)k * DEXP + (n >> 1)]; } };
struct SrcW2K { const float* W; __device__ __forceinline__ float operator()(int k, int n) const { return W[(size_t)k * 64 + rope_od(n)]; } };
struct SrcW1K { const float* W; __device__ __forceinline__ float operator()(int k, int n) const { const int kr = (k & ~63) + rope_od(k & 63); return W[(size_t)kr * 256 + n]; } };
template <class Src> __device__ __forceinline__ void tr_item(const Src& src, bf16_t* WT, int ldt, int k0, int n0, LAS float* scr, int lane) {
#pragma unroll 8
    for (int i = 0; i < 32; ++i) { const int kk = 2 * i + (lane >> 5); scr[kk * 33 + (lane & 31)] = src(k0 + kk, n0 + (lane & 31)); }
    LDS_WAIT(); asm volatile("" ::: "memory");
    const int c = lane & 7;
#pragma unroll
    for (int j = 0; j < 4; ++j) { const int n = (lane >> 3) + 8 * j; const LAS float* s = scr + (8 * c) * 33 + n;
        u32x4 o; o.x = pk2(s[0 * 33], s[1 * 33]); o.y = pk2(s[2 * 33], s[3 * 33]); o.z = pk2(s[4 * 33], s[5 * 33]); o.w = pk2(s[6 * 33], s[7 * 33]);
        *(u32x4*)(WT + (size_t)(n0 + n) * ldt + k0 + 8 * c) = o; }
    LDS_WAIT(); asm volatile("" ::: "memory");
}
template <class Src> __device__ __forceinline__ void tr_matrix(const Src& src, bf16_t* WT, int K, int N, LAS float* scr, int lane, int gw, int NGW, int& cursor) {
    const int nblk = N / 32, nit = (K / 64) * nblk;
    int first = (gw - cursor % NGW + NGW) % NGW;
    for (int it = first; it < nit; it += NGW) tr_item(src, WT, K, 64 * (it / nblk), 32 * (it % nblk), scr, lane);
    cursor += nit;
}

__device__ __forceinline__ void ph_prologue(const Params& p, const Ctx& c) {
    LAS float* scr = (LAS float*)(c.lds + c.wave * 8704);
    const int gw = c.vb * 8 + c.wave, NGW = c.nvb * 8;
    unsigned char* ws = p.ws;
    int cur = 0;
    tr_matrix(SrcWin{p.w_in}, (bf16_t*)(ws + WS_WIN_T), DM, NPROJ, scr, c.lane(), gw, NGW, cur);
    tr_matrix(SrcPlain{p.w_out, DM}, (bf16_t*)(ws + WS_WO_T), DM, DM, scr, c.lane(), gw, NGW, cur);
    tr_matrix(SrcPlain{p.w_router, NEXP}, (bf16_t*)(ws + WS_WR_T), DM, NEXP, scr, c.lane(), gw, NGW, cur);
    tr_matrix(SrcGU{p.w_sh_gate, p.w_sh_up}, (bf16_t*)(ws + WS_WSGU_T), DM, 2 * DEXP, scr, c.lane(), gw, NGW, cur);
    tr_matrix(SrcPlain{p.w_sh_down, DM}, (bf16_t*)(ws + WS_WSD_T), DEXP, DM, scr, c.lane(), gw, NGW, cur);
    tr_matrix(SrcW1K{p.cmp_w1_k}, (bf16_t*)(ws + WS_W1K_T), 2048, 256, scr, c.lane(), gw, NGW, cur);
    tr_matrix(SrcPlain{p.cmp_w1_v, 256}, (bf16_t*)(ws + WS_W1V_T), 2048, 256, scr, c.lane(), gw, NGW, cur);
    tr_matrix(SrcW2K{p.cmp_w2_k}, (bf16_t*)(ws + WS_W2K_T), 256, 64, scr, c.lane(), gw, NGW, cur);
    tr_matrix(SrcPlain{p.cmp_w2_v, 64}, (bf16_t*)(ws + WS_W2V_T), 256, 64, scr, c.lane(), gw, NGW, cur);
    const size_t gt = (size_t)c.vb * 512 + c.tid(), NGT = (size_t)c.nvb * 512;
    { const f32x4* xs = (const f32x4*)p.x; u32x4* xd = (u32x4*)(ws + WS_XB);
      for (size_t i = gt; i < (size_t)NT * DM / 8; i += NGT) { const f32x4 a = xs[2 * i], b = xs[2 * i + 1]; u32x4 o; o.x = pk2(a.x, a.y); o.y = pk2(a.z, a.w); o.z = pk2(b.x, b.y); o.w = pk2(b.z, b.w); xd[i] = o; } }
    { float* cs = (float*)(ws + WS_COS); float* sn = (float*)(ws + WS_SIN);
      for (size_t i = gt; i < (size_t)NT * 32; i += NGT) { const int t = (int)(i >> 5), f = (int)(i & 31);
        const float inv = powf(10000.0f, -(float)f / 32.0f); const float ang = (float)p.positions[t] * inv; float s, co; sincosf(ang, &s, &co); cs[i] = co; sn[i] = s; } }
    if (c.vb < 64) { const int t = c.tid(), which = t >> 8, j = t & 255, m0 = c.vb * 32; const float* pos = which ? p.cmp_pos_v : p.cmp_pos_k; const float* w1 = which ? p.cmp_w1_v : p.cmp_w1_k;
        float a = 0.f;
#pragma unroll
        for (int m = 0; m < 32; ++m) a += pos[m0 + m] * w1[(size_t)(m0 + m) * 256 + j];
        ((float*)(ws + WS_BIASKV))[c.vb * 512 + t] = a; }
}
__device__ __forceinline__ void conv_wgu(const Params& p, const Ctx& c, int first_wave, int nwaves_total, int it_end) {
    LAS float* scr = (LAS float*)(c.lds + c.wave * 8704);
    constexpr int PER = (DM / 64) * (2 * DEXP / 32);
    for (int it = first_wave; it < it_end; it += nwaves_total) { const int e = it / PER, r = it % PER;
        tr_item(SrcGU{p.w_exp_gate + (size_t)e * DM * DEXP, p.w_exp_up + (size_t)e * DM * DEXP}, (bf16_t*)(p.ws + WS_WGU_T) + (size_t)e * 2 * DEXP * DM, DM, 64 * (r / 16), 32 * (r % 16), scr, c.lane()); }
}
__device__ __forceinline__ void conv_wd(const Params& p, const Ctx& c, int first_wave, int nwaves_total, int it_end) {
    LAS float* scr = (LAS float*)(c.lds + c.wave * 8704);
    constexpr int PER = (DEXP / 64) * (DM / 32);
    for (int it = first_wave; it < it_end; it += nwaves_total) { const int e = it / PER, r = it % PER;
        tr_item(SrcPlain{p.w_exp_down + (size_t)e * DEXP * DM, DM}, (bf16_t*)(p.ws + WS_WD_T) + (size_t)e * DM * DEXP, DEXP, 64 * (r / 32), 32 * (r % 32), scr, c.lane()); }
}
struct SchedPlain {
    const char* A; const char* Bt; int lda, K, nM, nN, G, c;
    __device__ __forceinline__ bool next(int i, pg8::Unit& u) const {
        const long L = (long)i * G + c; const int nwg = nM * nN; if (L >= nwg) return false;
        int wgid = (int)L; { const int q = nwg / 8, r = nwg % 8, xcd = wgid % 8, off = wgid / 8; wgid = (xcd < r ? xcd * (q + 1) : r * (q + 1) + (xcd - r) * q) + off; }
        const int nig = 8 * nN, gid = wgid / nig, fm = gid * 8, gsz = (nM - fm) < 8 ? (nM - fm) : 8;
        u.pm = fm + ((wgid % nig) % gsz); u.pn = (wgid % nig) / gsz; u.a0 = 0; u.a1 = 0; return true;
    }
    __device__ __forceinline__ const char* a_base(const pg8::Unit& u) const { return A + (size_t)u.pm * 256 * lda * 2; }
    __device__ __forceinline__ unsigned a_off(const pg8::Unit&, int row, int C) const { return (unsigned)(row * lda + C) * 2u; }
    __device__ __forceinline__ size_t a_kstep() const { return 128; }
    __device__ __forceinline__ const char* b_base(const pg8::Unit& u) const { return Bt + (size_t)u.pn * 256 * K * 2; }
};
struct SchedCmp {
    const char* proj; const char* W1k; const char* W1v; int G, c;
    __device__ __forceinline__ bool next(int i, pg8::Unit& u) const { const int L = i * G + c; if (L >= 64) return false; u.pm = L >> 1; u.a0 = L & 1; u.pn = 0; u.a1 = 0; return true; }
    __device__ __forceinline__ const char* a_base(const pg8::Unit& u) const { return proj + ((size_t)u.pm * SEQ * NPROJ + (u.a0 ? PC_NVC : PC_NKC)) * 2; }
    __device__ __forceinline__ unsigned a_off(const pg8::Unit&, int row, int C) const { return (unsigned)((row & 127) * 16 * NPROJ + (row >> 7) * 64 + C) * 2u; }
    __device__ __forceinline__ size_t a_kstep() const { return (size_t)NPROJ * 2; }
    __device__ __forceinline__ const char* b_base(const pg8::Unit& u) const { return u.a0 ? W1v : W1k; }
};

struct EpiProj {
    static constexpr bool PERM = true, AFTER_DRAIN = false;
    bf16_t* O; const float* cs; const float* sn;
    __device__ __forceinline__ void operator()(const f32x4 (&acc)[2][2][4][2], const pg8::Unit& u, int wr, int wc, int fr, int fq) const {
        const int row0 = u.pm * 256 + wr * 64 + fr, pn = u.pn;
        const int nb = (pn >= 6 && pn <= 8) ? 2 : ((pn == 9) ? 1 : 0);
#pragma unroll
        for (int am = 0; am < 4; ++am) { const int ai = am >> 1;
            f32x4 c4[4][2], s4[4][2];
#pragma unroll
            for (int m = 2 * (am & 1); m < 2 * (am & 1) + 2; ++m)
#pragma unroll
                for (int bj = 0; bj < 2; ++bj) if (bj < nb) { const int row = row0 + ai * 128 + m * 16, i0 = ((bj * 128 + wc * 32 + 8 * fq) & 63) >> 1;
                    c4[m][bj] = *(const f32x4*)(cs + (size_t)row * 32 + i0); s4[m][bj] = *(const f32x4*)(sn + (size_t)row * 32 + i0); }
#pragma unroll
            for (int m = 2 * (am & 1); m < 2 * (am & 1) + 2; ++m) { const int row = row0 + ai * 128 + m * 16;
#pragma unroll
                for (int bj = 0; bj < 2; ++bj) { const int col0 = pn * 256 + bj * 128 + wc * 32 + 8 * fq;
                    f32x4 v0 = acc[ai][bj][m][0], v1 = acc[ai][bj][m][1];
                    if (bj < nb) { const f32x4 cc = c4[m][bj], ss = s4[m][bj];
                        v0 = (f32x4){v0[0] * cc[0] - v0[1] * ss[0], v0[1] * cc[0] + v0[0] * ss[0], v0[2] * cc[1] - v0[3] * ss[1], v0[3] * cc[1] + v0[2] * ss[1]};
                        v1 = (f32x4){v1[0] * cc[2] - v1[1] * ss[2], v1[1] * cc[2] + v1[0] * ss[2], v1[2] * cc[3] - v1[3] * ss[3], v1[3] * cc[3] + v1[2] * ss[3]}; }
                    u32x4 w; w.x = pk2(v0[0], v0[1]); w.y = pk2(v0[2], v0[3]); w.z = pk2(v1[0], v1[1]); w.w = pk2(v1[2], v1[3]);
                    *(u32x4*)(O + (size_t)row * NPROJ + col0) = w; } } }
    }
};
struct EpiAxpyF32 {
    static constexpr bool PERM = false, AFTER_DRAIN = false;
    const float* base; float* out; int ldc; float alpha;
    __device__ __forceinline__ void operator()(const f32x4 (&acc)[2][2][4][2], const pg8::Unit& u, int wr, int wc, int fr, int fq) const {
        const int row0 = u.pm * 256 + wr * 64 + fr;
#pragma unroll
        for (int am = 0; am < 4; ++am) { const int ai = am >> 1;
            f32x4 bv[2][2][2];
            if (base) {
#pragma unroll
                for (int mm = 0; mm < 2; ++mm) { const int m = 2 * (am & 1) + mm; const size_t ro = (size_t)(row0 + ai * 128 + m * 16) * ldc;
#pragma unroll
                    for (int bj = 0; bj < 2; ++bj)
#pragma unroll
                        for (int n = 0; n < 2; ++n) bv[mm][bj][n] = *(const f32x4*)(base + ro + u.pn * 256 + bj * 128 + wc * 32 + n * 16 + 4 * fq); } }
#pragma unroll
            for (int mm = 0; mm < 2; ++mm) { const int m = 2 * (am & 1) + mm; const size_t ro = (size_t)(row0 + ai * 128 + m * 16) * ldc;
#pragma unroll
                for (int bj = 0; bj < 2; ++bj)
#pragma unroll
                    for (int n = 0; n < 2; ++n) { const int col = u.pn * 256 + bj * 128 + wc * 32 + n * 16 + 4 * fq;
                        f32x4 o = acc[ai][bj][m][n]; if (base) o = bv[mm][bj][n] * alpha + o;
                        *(f32x4*)(out + ro + col) = o; } } }
    }
};
__device__ __forceinline__ float gelu_tanh(float x) { const float u = 0.7978845608028654f * (x + 0.044715f * x * x * x); const float e = __expf(2.f * u); const float t = 1.f - 2.f / (e + 1.f); return 0.5f * x * (1.f + t); }
struct EpiCmp {
    static constexpr bool PERM = false, AFTER_DRAIN = true;
    const LAS float* bias; const bf16_t* w2kt; const bf16_t* w2vt; bf16_t* kc; bf16_t* vc;
    __device__ __forceinline__ void fused(f32x4 (&acc)[2][2][4][2], const pg8::Unit& u, int wr, int wc, int fr, int fq, LAS unsigned char* lds, int wid, int lane) const {
        const int which = u.a0;
#pragma unroll
        for (int bj = 0; bj < 2; ++bj)
#pragma unroll
            for (int n = 0; n < 2; ++n) { const int col = bj * 128 + wc * 32 + n * 16 + 4 * fq; const f32x4 bv = *(const LAS f32x4*)(bias + col);
#pragma unroll
                for (int ai = 0; ai < 2; ++ai)
#pragma unroll
                    for (int m = 0; m < 4; ++m) { const int row = ai * 128 + wr * 64 + m * 16 + fr; const f32x4 v = acc[ai][bj][m][n] + bv;
                        u32x2 o; o.x = pk2(gelu_tanh(v[0]), gelu_tanh(v[1])); o.y = pk2(gelu_tanh(v[2]), gelu_tanh(v[3]));
                        *(LAS u32x2*)(lds + row * 512 + (((col >> 3) ^ (row & 15)) << 4) + (col & 7) * 2) = o; } }
        LDS_WAIT(); __syncthreads();
        const int r32 = lane & 31, h = lane >> 5, row = wid * 32 + r32;
        const bf16_t* w2t = which ? w2vt : w2kt;
        f32x16 o0 = {}, o1 = {};
#pragma unroll 4
        for (int s = 0; s < 16; ++s) { const bf16x8 hb = *(const LAS bf16x8*)(lds + row * 512 + (((2 * s + h) ^ (row & 15)) << 4));
            const bf16x8 w0 = *(const bf16x8*)(w2t + (size_t)r32 * 256 + 16 * s + 8 * h), w1 = *(const bf16x8*)(w2t + (size_t)(32 + r32) * 256 + 16 * s + 8 * h);
            o0 = __builtin_amdgcn_mfma_f32_32x32x16_bf16(w0, hb, o0, 0, 0, 0); o1 = __builtin_amdgcn_mfma_f32_32x32x16_bf16(w1, hb, o1, 0, 0, 0); }
        const int g = row >> 7, n = row & 127; bf16_t* dst = (which ? vc : kc) + ((size_t)(u.pm * 2 + g) * 128 + n) * 64;
        const float keep = (n == 127) ? 0.f : 1.f;
#pragma unroll
        for (int rq = 0; rq < 4; ++rq) { u32x2 a, b; a.x = pk2(o0[4 * rq] * keep, o0[4 * rq + 1] * keep); a.y = pk2(o0[4 * rq + 2] * keep, o0[4 * rq + 3] * keep);
            b.x = pk2(o1[4 * rq] * keep, o1[4 * rq + 1] * keep); b.y = pk2(o1[4 * rq + 2] * keep, o1[4 * rq + 3] * keep);
            *(u32x2*)(dst + 8 * rq + 4 * h) = a; *(u32x2*)(dst + 32 + 8 * rq + 4 * h) = b; }
        __syncthreads();
    }
};
typedef short v4i16_t __attribute__((ext_vector_type(4)));
__device__ __forceinline__ s16x4 tr_rd(const LAS unsigned char* p) { return __builtin_bit_cast(s16x4, __builtin_amdgcn_ds_read_tr16_b64_v4i16((LAS v4i16_t*)p)); }
__device__ __forceinline__ bf16x8 cat8(s16x4 lo, s16x4 hi) { return (bf16x8){lo[0], lo[1], lo[2], lo[3], hi[0], hi[1], hi[2], hi[3]}; }
#define MFMA32(a, b, c) __builtin_amdgcn_mfma_f32_32x32x16_bf16((a), (b), (c), 0, 0, 0)
__device__ __forceinline__ bf16x8 ld16(const LAS unsigned char* p) { return *(const LAS bf16x8*)p; }

__device__ __forceinline__ void gla_prep_unit(const Params& p, const Ctx& c, int unit) {
    LAS bf16_t* Tq = (LAS bf16_t*)c.lds; LAS bf16_t* Tk = Tq + 16384; LAS bf16_t* Tl = Tk + 16384;
    LAS float* ga = (LAS float*)(c.lds + 98304); LAS float* tot = ga + 1024;
    const bf16_t* proj = (const bf16_t*)(p.ws + WS_PROJ);
    const size_t row0 = (size_t)unit * 64;
#pragma unroll
    for (int k = 0; k < 4; ++k) { const int idx = c.tid() + 512 * k, r = idx >> 5, ch = idx & 31;
        *(LAS u32x4*)(Tq + r * 256 + ch * 8) = *(const u32x4*)(proj + (row0 + r) * NPROJ + PC_GQ + ch * 8);
        *(LAS u32x4*)(Tk + r * 256 + ch * 8) = *(const u32x4*)(proj + (row0 + r) * NPROJ + PC_GK + ch * 8); }
    for (int i = c.tid(); i < 1024; i += 512) ga[i] = bf2f(proj[(row0 + (i >> 4)) * NPROJ + PC_GA + (i & 15)]);
    const int col = c.tid() & 255, half = c.tid() >> 8;
    float w[16];
#pragma unroll
    for (int k = 0; k < 16; ++k) w[k] = p.w_alpha2[k * 256 + col];
    const float bal = p.b_alpha[col];
    LDS_WAIT(); __syncthreads();
    float bl[32]; float csum = 0.f;
#pragma unroll
    for (int r = 0; r < 32; ++r) { const LAS float* g = ga + (half * 32 + r) * 16; float z = bal;
#pragma unroll
        for (int k = 0; k < 16; ++k) z += g[k] * w[k];
        const float ls = fminf(z, 0.f) - __logf(1.0f + __expf(-fabsf(z)));
        csum += ls * (1.0f / 16.0f); bl[r] = csum; }
    if (half == 0) tot[col] = csum;
    __syncthreads();
    const float off = half ? tot[col] : 0.f;
    __syncthreads();
    if (half == 1) tot[col] = csum + off;
    __syncthreads();
    const float blast = tot[col];
#pragma unroll
    for (int r = 0; r < 32; ++r) { const float b = bl[r] + off; const int rr = half * 32 + r;
        const float q = bf2f(Tq[rr * 256 + col]), k = bf2f(Tk[rr * 256 + col]);
        Tq[rr * 256 + col] = (bf16_t)f2bf(q * __expf(b)); Tk[rr * 256 + col] = (bf16_t)f2bf(k * __expf(-b)); Tl[rr * 256 + col] = (bf16_t)f2bf(k * __expf(blast - b)); }
    if (half == 0) ((float*)(p.ws + WS_EBL))[(size_t)unit * 256 + col] = __expf(blast);
    LDS_WAIT(); __syncthreads();
    bf16_t* QB = (bf16_t*)(p.ws + WS_QB); bf16_t* KB = (bf16_t*)(p.ws + WS_KB); bf16_t* KL = (bf16_t*)(p.ws + WS_KL);
#pragma unroll
    for (int k = 0; k < 4; ++k) { const int idx = c.tid() + 512 * k, r = idx >> 5, ch = idx & 31;
        *(u32x4*)(QB + (row0 + r) * 256 + ch * 8) = *(const LAS u32x4*)(Tq + r * 256 + ch * 8);
        *(u32x4*)(KB + (row0 + r) * 256 + ch * 8) = *(const LAS u32x4*)(Tk + r * 256 + ch * 8);
        *(u32x4*)(KL + (row0 + r) * 256 + ch * 8) = *(const LAS u32x4*)(Tl + r * 256 + ch * 8); }
    LDS_WAIT(); __syncthreads();
}

constexpr int GL_QB = 0, GL_KB = 9216, GL_KL = 18432, GL_V = 26624, GL_ATT = 43008, GL_ST = 52224, GL_O = 70656, GL_EB = 104448, GL_END = 104704;
__device__ __forceinline__ void gla_unit(const Params& p, const Ctx& c, int unit) {
    const int b = unit >> 2, hd = unit & 3;
    LAS unsigned char* L = c.lds;
    const int tid = c.tid(), lane = c.lane(), w = c.wave, r32 = lane & 31, h = lane >> 5, gi = (lane >> 4) & 1, li = lane & 15;
    const bf16_t* QB = (const bf16_t*)(p.ws + WS_QB); const bf16_t* KB = (const bf16_t*)(p.ws + WS_KB); const bf16_t* KL = (const bf16_t*)(p.ws + WS_KL);
    const bf16_t* proj = (const bf16_t*)(p.ws + WS_PROJ); const float* EBL = (const float*)(p.ws + WS_EBL);
    bf16_t* MIX = (bf16_t*)(p.ws + WS_MIX);
    const int ci = w >> 2, ei = w & 3;
    const int lr = tid >> 3, lch = tid & 7;
    u32x4 pq, pk, pl, pv0, pv1; float peb = 0.f;
    auto gload = [&](int chunk) {
        const size_t row = (size_t)b * SEQ + chunk * 64;
        pq = *(const u32x4*)(QB + (row + lr) * 256 + hd * 64 + lch * 8);
        pk = *(const u32x4*)(KB + (row + lr) * 256 + hd * 64 + lch * 8);
        pl = *(const u32x4*)(KL + (row + lr) * 256 + hd * 64 + lch * 8);
        { const int i0 = tid, i1 = tid + 512;
          pv0 = *(const u32x4*)(proj + (row + (i0 >> 4)) * NPROJ + PC_GV + hd * 128 + (i0 & 15) * 8);
          pv1 = *(const u32x4*)(proj + (row + (i1 >> 4)) * NPROJ + PC_GV + hd * 128 + (i1 & 15) * 8); }
        if (tid < 64) peb = EBL[((size_t)b * 32 + chunk) * 256 + hd * 64 + tid];
    };
    auto lstore = [&]() {
        *(LAS u32x4*)(L + GL_QB + (lr * 72 + lch * 8) * 2) = pq;
        *(LAS u32x4*)(L + GL_KB + (lr * 72 + lch * 8) * 2) = pk;
        *(LAS u32x4*)(L + GL_KL + (lch >> 2) * 4096 + lr * 64 + (lch & 3) * 16) = pl;
        { const int i0 = tid, i1 = tid + 512;
          *(LAS u32x4*)(L + GL_V + ((i0 & 15) >> 2) * 4096 + (i0 >> 4) * 64 + (i0 & 3) * 16) = pv0;
          *(LAS u32x4*)(L + GL_V + ((i1 & 15) >> 2) * 4096 + (i1 >> 4) * 64 + (i1 & 3) * 16) = pv1; }
        if (tid < 64) ((LAS float*)(L + GL_EB))[tid] = peb;
    };
    f32x16 S = {};
    gload(0); lstore(); LDS_WAIT(); __syncthreads();
    const int trA = (li >> 2) * 64 + (16 * gi + 4 * (li & 3)) * 2;
    for (int chunk = 0; chunk < 32; ++chunk) {
        if (chunk + 1 < 32) gload(chunk + 1);
#pragma unroll
        for (int rq = 0; rq < 4; ++rq) { u32x2 o2; o2.x = pk2(S[4 * rq], S[4 * rq + 1]); o2.y = pk2(S[4 * rq + 2], S[4 * rq + 3]);
            *(LAS u32x2*)(L + GL_ST + ((32 * ei + r32) * 72 + 32 * ci + 8 * rq + 4 * h) * 2) = o2; }
        if (w < 3) { const int aci = (w + 1) >> 1, acj = w >> 1;
            f32x16 a = {};
#pragma unroll
            for (int s = 0; s < 4; ++s) { const bf16x8 ka = ld16(L + GL_KB + ((32 * acj + r32) * 72 + 16 * s + 8 * h) * 2), qa = ld16(L + GL_QB + ((32 * aci + r32) * 72 + 16 * s + 8 * h) * 2);
                a = MFMA32(ka, qa, a); }
#pragma unroll
            for (int rq = 0; rq < 4; ++rq) { float v[4];
#pragma unroll
                for (int e = 0; e < 4; ++e) { const int j = 32 * acj + 8 * rq + 4 * h + e, cg = 32 * aci + r32; v[e] = (j <= cg) ? a[4 * rq + e] : 0.f; }
                u32x2 o2; o2.x = pk2(v[0], v[1]); o2.y = pk2(v[2], v[3]);
                *(LAS u32x2*)(L + GL_ATT + ((32 * aci + r32) * 72 + 32 * acj + 8 * rq + 4 * h) * 2) = o2; } }
        LDS_WAIT(); __syncthreads();
        bf16x8 vf[4];
#pragma unroll
        for (int s = 0; s < 4; ++s) { const LAS unsigned char* a0 = L + GL_V + ei * 4096 + (16 * s + 8 * h) * 64 + trA; vf[s] = cat8(tr_rd(a0), tr_rd(a0 + 256)); }
        f32x16 o = {};
#pragma unroll
        for (int s = 0; s < 4; ++s) { if (ci == 1 || s < 2) { const bf16x8 aa = ld16(L + GL_ATT + ((32 * ci + r32) * 72 + 16 * s + 8 * h) * 2); o = MFMA32(aa, vf[s], o); } }
#pragma unroll
        for (int s = 0; s < 4; ++s) { const bf16x8 qa = ld16(L + GL_QB + ((32 * ci + r32) * 72 + 16 * s + 8 * h) * 2), sb = ld16(L + GL_ST + ((32 * ei + r32) * 72 + 16 * s + 8 * h) * 2); o = MFMA32(qa, sb, o); }
        { LAS float* LO = (LAS float*)(L + GL_O);
#pragma unroll
          for (int r = 0; r < 16; ++r) LO[(32 * ci + (r & 3) + 8 * (r >> 2) + 4 * h) * 132 + 32 * ei + r32] = o[r]; }
#pragma unroll
        for (int rq = 0; rq < 4; ++rq) { const f32x4 e4 = *(const LAS f32x4*)(L + GL_EB + (32 * ci + 8 * rq + 4 * h) * 4);
#pragma unroll
            for (int e = 0; e < 4; ++e) S[4 * rq + e] *= e4[e]; }
#pragma unroll
        for (int s = 0; s < 4; ++s) { const LAS unsigned char* a0 = L + GL_KL + ci * 4096 + (16 * s + 8 * h) * 64 + trA; const bf16x8 ka = cat8(tr_rd(a0), tr_rd(a0 + 256)); S = MFMA32(ka, vf[s], S); }
        LDS_WAIT(); __syncthreads();
        { const int tok = tid >> 3, part = tid & 7; const LAS float* LO = (const LAS float*)(L + GL_O) + tok * 132 + part * 16;
          f32x4 v4[4]; float ss = 0.f;
#pragma unroll
          for (int q = 0; q < 4; ++q) { v4[q] = *(const LAS f32x4*)(LO + 4 * q); ss += v4[q].x * v4[q].x + v4[q].y * v4[q].y + v4[q].z * v4[q].z + v4[q].w * v4[q].w; }
          ss += shx_(ss, 1); ss += shx_(ss, 2); ss += shx_(ss, 4);
          const float rs = rsqrtf(ss * (1.0f / 128.0f) + 1e-6f);
          const size_t row = (size_t)b * SEQ + chunk * 64 + tok;
          const u32x4 r0 = *(const u32x4*)(proj + row * NPROJ + PC_GR + hd * 128 + part * 16), r1 = *(const u32x4*)(proj + row * NPROJ + PC_GR + hd * 128 + part * 16 + 8);
          const unsigned rw[8] = {r0.x, r0.y, r0.z, r0.w, r1.x, r1.y, r1.z, r1.w};
          unsigned ow[8];
#pragma unroll
          for (int q = 0; q < 4; ++q) { const f32x4 g4 = *(const f32x4*)(p.gla_norm_g + part * 16 + 4 * q);
              const float a0 = v4[q].x * rs * g4.x * siluf_(bflo(rw[2 * q])), a1 = v4[q].y * rs * g4.y * siluf_(bfhi(rw[2 * q]));
              const float a2 = v4[q].z * rs * g4.z * siluf_(bflo(rw[2 * q + 1])), a3 = v4[q].w * rs * g4.w * siluf_(bfhi(rw[2 * q + 1]));
              ow[2 * q] = pk2(a0, a1); ow[2 * q + 1] = pk2(a2, a3); }
          *(u32x4*)(MIX + row * DM + hd * 128 + part * 16) = (u32x4){ow[0], ow[1], ow[2], ow[3]};
          *(u32x4*)(MIX + row * DM + hd * 128 + part * 16 + 8) = (u32x4){ow[4], ow[5], ow[6], ow[7]}; }
        if (chunk + 1 < 32) lstore();
        LDS_WAIT(); __syncthreads();
    }
}
constexpr int NS_BUF = 17408, NS_K = 0, NS_V = 9216, NS_IMP = 69632, NS_SEL = NS_IMP + 32768, NS_END = NS_SEL + 256;
constexpr float ATT_THR = 8.0f;
constexpr int NB2_K = 0, NB2_V = 18432, NB2_BUF = 18432 + 16384;
#define ATT_PV(P, keyoff) _Pragma("unroll") for (int s = 0; s < 2; ++s) { u32x4 pw; pw.x = pk2(P[8 * s], P[8 * s + 1]); pw.y = pk2(P[8 * s + 2], P[8 * s + 3]); pw.z = pk2(P[8 * s + 4], P[8 * s + 5]); pw.w = pk2(P[8 * s + 6], P[8 * s + 7]); \
        const bf16x8 pf = __builtin_bit_cast(bf16x8, pw); _Pragma("unroll") for (int dh = 0; dh < 2; ++dh) { const LAS unsigned char* a0 = Vb + dh * 8192 + ((keyoff) + 16 * s + 4 * h) * 64 + trA; \
            O[dh] = MFMA32(cat8(tr_rd(a0), tr_rd(a0 + 512)), pf, O[dh]); } }
__device__ __forceinline__ void attn_tile2(const LAS unsigned char* Kb, const LAS unsigned char* Vb, const bf16x8 (&Qf)[4], int kminA, int kmaxA, int kminB, int kmaxB, bool nomask, bool first, bool useB,
                                           int r32, int h, int trA, float& m, float& l, f32x16& negm, f32x16 (&O)[2]) {
    f32x16 p0, p1, p2, p3;
#pragma unroll
    for (int s = 0; s < 4; ++s) { const bf16x8 a0 = ld16(Kb + (r32 * 72 + 16 * s + 8 * h) * 2), a1 = ld16(Kb + ((32 + r32) * 72 + 16 * s + 8 * h) * 2);
        if (s == 0) { p0 = MFMA32(a0, Qf[s], negm); p1 = MFMA32(a1, Qf[s], negm); } else { p0 = MFMA32(a0, Qf[s], p0); p1 = MFMA32(a1, Qf[s], p1); } }
    if (useB) {
#pragma unroll
        for (int s = 0; s < 4; ++s) { const bf16x8 a2 = ld16(Kb + ((64 + r32) * 72 + 16 * s + 8 * h) * 2), a3 = ld16(Kb + ((96 + r32) * 72 + 16 * s + 8 * h) * 2);
            if (s == 0) { p2 = MFMA32(a2, Qf[s], negm); p3 = MFMA32(a3, Qf[s], negm); } else { p2 = MFMA32(a2, Qf[s], p2); p3 = MFMA32(a3, Qf[s], p3); } }
    } else {
#pragma unroll
        for (int r = 0; r < 16; ++r) { p2[r] = -INFINITY; p3[r] = -INFINITY; } }
    if (!nomask) {
#pragma unroll
        for (int r = 0; r < 16; ++r) { const int ko = (r & 3) + 8 * (r >> 2) + 4 * h;
            p0[r] = (ko >= kminA && ko <= kmaxA) ? p0[r] : -INFINITY; p1[r] = (ko + 32 >= kminA && ko + 32 <= kmaxA) ? p1[r] : -INFINITY;
            p2[r] = (ko >= kminB && ko <= kmaxB) ? p2[r] : -INFINITY; p3[r] = (ko + 32 >= kminB && ko + 32 <= kmaxB) ? p3[r] : -INFINITY; } }
    float mx = fmaxf(fmaxf(p0[0], p1[0]), fmaxf(p2[0], p3[0]));
#pragma unroll
    for (int r = 1; r < 16; ++r) mx = fmaxf(mx, fmaxf(fmaxf(p0[r], p1[r]), fmaxf(p2[r], p3[r])));
    mx = fmaxf(mx, shx_(mx, 32));
    if (first || __any(mx > ATT_THR)) {
        const float d = first ? ((mx == -INFINITY) ? 0.f : mx) : fmaxf(mx, 0.f);
        m += d;
#pragma unroll
        for (int r = 0; r < 16; ++r) { p0[r] -= d; p1[r] -= d; p2[r] -= d; p3[r] -= d; negm[r] = -m; }
        asm volatile("" : "+v"(negm));
        if (!first) { const float alpha = __builtin_amdgcn_exp2f(-d); l *= alpha;
#pragma unroll
            for (int r = 0; r < 16; ++r) { O[0][r] *= alpha; O[1][r] *= alpha; } }
    }
    float rs = 0.f;
#pragma unroll
    for (int r = 0; r < 16; ++r) { p0[r] = __builtin_amdgcn_exp2f(p0[r]); p1[r] = __builtin_amdgcn_exp2f(p1[r]); rs += p0[r] + p1[r]; }
    ATT_PV(p0, 0) ATT_PV(p1, 32)
    if (useB) {
#pragma unroll
        for (int r = 0; r < 16; ++r) { p2[r] = __builtin_amdgcn_exp2f(p2[r]); p3[r] = __builtin_amdgcn_exp2f(p3[r]); rs += p2[r] + p3[r]; }
        ATT_PV(p2, 64) ATT_PV(p3, 96)
    }
    l += rs;
}

template <int MODE> __device__ __forceinline__ void nsa_fold(LAS unsigned* park, bf16_t* mixrow, const f32x16 (&O)[2], float scale, int h) {
#pragma unroll
    for (int dh = 0; dh < 2; ++dh)
#pragma unroll
        for (int rq = 0; rq < 4; ++rq) {
            float v0 = scale * O[dh][4 * rq], v1 = scale * O[dh][4 * rq + 1], v2 = scale * O[dh][4 * rq + 2], v3 = scale * O[dh][4 * rq + 3];
            if (MODE != 0) { const u32x2 old = *(const LAS u32x2*)(park + 8 * dh + 2 * rq); v0 += bflo(old.x); v1 += bfhi(old.x); v2 += bflo(old.y); v3 += bfhi(old.y); }
            u32x2 o2; o2.x = pk2(v0, v1); o2.y = pk2(v2, v3);
            if (MODE == 2) *(u32x2*)(mixrow + 32 * dh + 8 * rq + 4 * h) = o2; else *(LAS u32x2*)(park + 8 * dh + 2 * rq) = o2; }
}
__device__ __forceinline__ void nsa_unit(const Params& p, const Ctx& c, int unit) {
    const int tile = 31 - (unit >> 6), bg = unit & 63, b = bg >> 1, g = bg & 1, cur = tile, t0 = tile * 64;
    LAS unsigned char* L = c.lds;
    const int tid = c.tid(), lane = c.lane(), w = c.wave, r32 = lane & 31, h = lane >> 5, gi = (lane >> 4) & 1, li = lane & 15;
    const int hh = w >> 1, th = w & 1, hq = g * 4 + hh, qo = 32 * th + r32;
    const int trA = (li >> 2) * 64 + (16 * gi + 4 * (li & 3)) * 2;
    const bf16_t* proj = (const bf16_t*)(p.ws + WS_PROJ);
    const size_t rowb = (size_t)b * SEQ;
    const size_t qrow = rowb + t0 + qo;
    bf16x8 Qf[4];
#pragma unroll
    for (int s = 0; s < 4; ++s) Qf[s] = *(const bf16x8*)(proj + qrow * NPROJ + PC_NQ + hq * 64 + 16 * s + 8 * h);
    float g0, g1, g2;
    { const bf16_t* gp = proj + qrow * NPROJ + PC_NG + hq * 3; g0 = sigmoidf_(bf2f(gp[0])); g1 = sigmoidf_(bf2f(gp[1])); g2 = sigmoidf_(bf2f(gp[2])); }
    const int skey = tid >> 3, sch = tid & 7;
    const int kdst = (skey * 72 + sch * 8) * 2, vdst = (sch >> 2) * 4096 + skey * 64 + (sch & 3) * 16;
    u32x4 pkr, pvr;
    const bool useB = (t0 + 32) >= 1024;
    { const bf16_t* KC = (const bf16_t*)(p.ws + WS_KC) + (size_t)bg * 128 * 64; const bf16_t* VC = (const bf16_t*)(p.ws + WS_VC) + (size_t)bg * 128 * 64;
      pkr = *(const u32x4*)(KC + skey * 64 + sch * 8); pvr = *(const u32x4*)(VC + skey * 64 + sch * 8);
      *(LAS u32x4*)(L + NS_K + kdst) = pkr; *(LAS u32x4*)(L + NS_V + vdst) = pvr;
      if (useB) { pkr = *(const u32x4*)(KC + (64 + skey) * 64 + sch * 8); pvr = *(const u32x4*)(VC + (64 + skey) * 64 + sch * 8);
          *(LAS u32x4*)(L + NS_BUF + NS_K + kdst) = pkr; *(LAS u32x4*)(L + NS_BUF + NS_V + vdst) = pvr; } }
    const int nsel = cur + 1, nwin = (cur < 8 ? cur : 8) + 1, npsel = (nsel + 1) >> 1, npwin = (nwin + 1) >> 1, npair = npsel + npwin;
    u32x4 pkA, pvA, pkB, pvB;
    auto tile_j = [&](int q, int sub, bool& exists, bool& win) -> int { win = q >= npsel; const int i = 2 * (win ? q - npsel : q) + sub; exists = i < (win ? nwin : nsel);
        return win ? cur - i : (i == 0 ? cur : i - 1); };
#define NSA_GLOAD(q) do { bool exA_, exB_, w_; const int jA_ = tile_j((q), 0, exA_, w_); const int jB_ = tile_j((q), 1, exB_, w_); const int kc_ = w_ ? PC_NKW : PC_NKS, vc_ = w_ ? PC_NVW : PC_NVS; \
        pkA = *(const u32x4*)(proj + (rowb + 64 * jA_ + skey) * NPROJ + kc_ + g * 64 + sch * 8); pvA = *(const u32x4*)(proj + (rowb + 64 * jA_ + skey) * NPROJ + vc_ + g * 64 + sch * 8); \
        if (exB_) { pkB = *(const u32x4*)(proj + (rowb + 64 * jB_ + skey) * NPROJ + kc_ + g * 64 + sch * 8); pvB = *(const u32x4*)(proj + (rowb + 64 * jB_ + skey) * NPROJ + vc_ + g * 64 + sch * 8); } } while (0)
#define NSA_LSTORE(buf) do { LAS unsigned char* nb_ = L + (buf) * NB2_BUF; *(LAS u32x4*)(nb_ + NB2_K + kdst) = pkA; *(LAS u32x4*)(nb_ + NB2_K + 64 * 144 + kdst) = pkB; \
        *(LAS u32x4*)(nb_ + NB2_V + vdst2) = pvA; *(LAS u32x4*)(nb_ + NB2_V + 64 * 64 + vdst2) = pvB; } while (0)
    const int vdst2 = (sch >> 2) * 8192 + skey * 64 + (sch & 3) * 16;
    pkB = (u32x4){0u, 0u, 0u, 0u}; pvB = pkB;
    NSA_GLOAD(0);
    LDS_WAIT(); __syncthreads();
    bf16_t* mixrow = (bf16_t*)(p.ws + WS_MIX) + qrow * DM + 512 + hq * 64;
    LAS unsigned* park = (LAS unsigned*)(L + NS_IMP) + (w * 64 + lane) * 16;
    f32x16 ocmp[2];
    {
        const int t = t0 + qo; const int nmax = (t >= 31) ? ((t - 31) >> 4) : -1;
        f32x16 pa0 = {}, pa1 = {}, pb0 = {}, pb1 = {};
#pragma unroll
        for (int s = 0; s < 4; ++s) { const bf16x8 a0 = ld16(L + NS_K + (r32 * 72 + 16 * s + 8 * h) * 2), a1 = ld16(L + NS_K + ((32 + r32) * 72 + 16 * s + 8 * h) * 2);
            pa0 = MFMA32(a0, Qf[s], pa0); pa1 = MFMA32(a1, Qf[s], pa1); }
        if (useB) {
#pragma unroll
            for (int s = 0; s < 4; ++s) { const bf16x8 a0 = ld16(L + NS_BUF + NS_K + (r32 * 72 + 16 * s + 8 * h) * 2), a1 = ld16(L + NS_BUF + NS_K + ((32 + r32) * 72 + 16 * s + 8 * h) * 2);
                pb0 = MFMA32(a0, Qf[s], pb0); pb1 = MFMA32(a1, Qf[s], pb1); } }
        float mx = -INFINITY;
#pragma unroll
        for (int r = 0; r < 16; ++r) { const int n = (r & 3) + 8 * (r >> 2) + 4 * h;
            pa0[r] = (n <= nmax) ? pa0[r] : -INFINITY; pa1[r] = (n + 32 <= nmax) ? pa1[r] : -INFINITY;
            pb0[r] = (useB && n + 64 <= nmax) ? pb0[r] : -INFINITY; pb1[r] = (useB && n + 96 <= nmax) ? pb1[r] : -INFINITY;
            mx = fmaxf(fmaxf(mx, fmaxf(pa0[r], pa1[r])), fmaxf(pb0[r], pb1[r])); }
        mx = fmaxf(mx, shx_(mx, 32));
        const float ms = (mx == -INFINITY) ? 0.f : mx;
        float rs = 0.f;
#pragma unroll
        for (int r = 0; r < 16; ++r) { pa0[r] = __builtin_amdgcn_exp2f(pa0[r] - ms); pa1[r] = __builtin_amdgcn_exp2f(pa1[r] - ms); pb0[r] = __builtin_amdgcn_exp2f(pb0[r] - ms); pb1[r] = __builtin_amdgcn_exp2f(pb1[r] - ms);
            rs += (pa0[r] + pa1[r]) + (pb0[r] + pb1[r]); }
        rs += shx_(rs, 32);
        const float inv = rs > 0.f ? 1.0f / rs : 0.f;
#pragma unroll
        for (int r = 0; r < 16; ++r) { pa0[r] *= inv; pa1[r] *= inv; pb0[r] *= inv; pb1[r] *= inv; }
        { LAS float* IMP = (LAS float*)(L + NS_IMP) + ((size_t)hh * 64 + qo) * 32;
          float A[16], tl[16];
#pragma unroll
          for (int rq = 0; rq < 4; ++rq) {
              A[rq] = pa0[4 * rq] + pa0[4 * rq + 1] + pa0[4 * rq + 2] + 0.5f * pa0[4 * rq + 3]; tl[rq] = 0.5f * pa0[4 * rq + 3];
              A[4 + rq] = pa1[4 * rq] + pa1[4 * rq + 1] + pa1[4 * rq + 2] + 0.5f * pa1[4 * rq + 3]; tl[4 + rq] = 0.5f * pa1[4 * rq + 3];
              A[8 + rq] = pb0[4 * rq] + pb0[4 * rq + 1] + pb0[4 * rq + 2] + 0.5f * pb0[4 * rq + 3]; tl[8 + rq] = 0.5f * pb0[4 * rq + 3];
              A[12 + rq] = pb1[4 * rq] + pb1[4 * rq + 1] + pb1[4 * rq + 2] + 0.5f * pb1[4 * rq + 3]; tl[12 + rq] = 0.5f * pb1[4 * rq + 3]; }
          float prev = 0.f;
#pragma unroll
          for (int i = 0; i < 16; ++i) { const float ot = shx_(tl[i], 32); IMP[2 * i + h] = A[i] + (h ? ot : prev); prev = ot; } }
        f32x16 O[2]; O[0] = (f32x16){}; O[1] = (f32x16){};
#pragma unroll
        for (int tt = 0; tt < 2; ++tt) { if (tt == 0 || useB) {
#pragma unroll
            for (int hf = 0; hf < 2; ++hf)
#pragma unroll
                for (int s = 0; s < 2; ++s) { const f32x16& P = tt == 0 ? (hf == 0 ? pa0 : pa1) : (hf == 0 ? pb0 : pb1);
                    u32x4 pw; pw.x = pk2(P[8 * s], P[8 * s + 1]); pw.y = pk2(P[8 * s + 2], P[8 * s + 3]); pw.z = pk2(P[8 * s + 4], P[8 * s + 5]); pw.w = pk2(P[8 * s + 6], P[8 * s + 7]);
                    const bf16x8 pf = __builtin_bit_cast(bf16x8, pw);
#pragma unroll
                    for (int dh = 0; dh < 2; ++dh) { const LAS unsigned char* a0 = L + tt * NS_BUF + NS_V + dh * 4096 + (32 * hf + 16 * s + 4 * h) * 64 + trA;
                        O[dh] = MFMA32(cat8(tr_rd(a0), tr_rd(a0 + 512)), pf, O[dh]); } } } }
        ocmp[0] = O[0]; ocmp[1] = O[1];
    }
    LDS_WAIT(); __syncthreads();
    { const int tok = tid >> 3, sub = tid & 7; const LAS float* I0 = (const LAS float*)(L + NS_IMP) + tok * 32;
      float v[32];
#pragma unroll
      for (int q = 0; q < 8; ++q) { f32x4 s4 = *(const LAS f32x4*)(I0 + 4 * q);
#pragma unroll
          for (int hd = 1; hd < 4; ++hd) s4 += *(const LAS f32x4*)(I0 + hd * 64 * 32 + 4 * q);
          v[4 * q] = s4.x; v[4 * q + 1] = s4.y; v[4 * q + 2] = s4.z; v[4 * q + 3] = s4.w; }
#pragma unroll
      for (int k = 0; k < 32; ++k) v[k] = (k > cur) ? -INFINITY : ((k == 0 || k == cur || k == cur - 1) ? INFINITY : v[k]);
      unsigned bits = 0u;
#pragma unroll
      for (int jj = 0; jj < 4; ++jj) {
          float vj = 0.f;
#pragma unroll
          for (int k = 0; k < 32; ++k) vj = (k == 4 * sub + jj) ? v[k] : vj;
          const int j = 4 * sub + jj; int rank = 0;
#pragma unroll
          for (int k = 0; k < 32; ++k) rank += (v[k] > vj || (v[k] == vj && k < j)) ? 1 : 0;
          if (rank < 16 && j <= cur) bits |= 1u << j; }
      bits |= shx_(bits, 1); bits |= shx_(bits, 2); bits |= shx_(bits, 4);
      if (sub == 0) ((LAS unsigned*)(L + NS_SEL))[tok] = bits; }
    NSA_LSTORE(0);
    LDS_WAIT(); __syncthreads();
    nsa_fold<0>(park, mixrow, ocmp, g0, h);
    const unsigned selmask = ((const LAS unsigned*)(L + NS_SEL))[qo];
    float m = 0.f, l = 0.f; f32x16 O[2]; O[0] = (f32x16){}; O[1] = (f32x16){}; f32x16 negm = {};
    for (int q = 0; q < npair; ++q) {
        if (q + 1 < npair) NSA_GLOAD(q + 1);
        if (q == npsel) {
            const float lt = l + shx_(l, 32), inv = lt > 0.f ? g1 / lt : 0.f;
            nsa_fold<1>(park, mixrow, O, inv, h);
            O[0] = (f32x16){}; O[1] = (f32x16){}; m = 0.f; l = 0.f; negm = (f32x16){}; }
        bool exA, exB, wsel; const int jA = tile_j(q, 0, exA, wsel); const int jB = tile_j(q, 1, exB, wsel);
        const int qq = wsel ? q - npsel : q;
        int kminA = 0, kmaxA = 63, kminB = 0, kmaxB = 63; bool nomask = true, anyrow = true;
        if (!wsel) { const bool sA = (selmask >> jA) & 1u, sB = exB && ((selmask >> jB) & 1u);
            if (qq == 0) { kmaxA = qo; nomask = false; }
            if (!sA) kmaxA = -1; if (!sB) kmaxB = -1;
            if (!__all(sA && (sB || !exB))) nomask = false;
            anyrow = __any(sA || sB); }
        else { if (qq == 0) { kmaxA = qo; nomask = false; }
            if (2 * qq == 8) { kminA = qo + 1; nomask = false; } }
        const LAS unsigned char* bufp = L + (q & 1) * NB2_BUF;
        if (anyrow) attn_tile2(bufp + NB2_K, bufp + NB2_V, Qf, kminA, kmaxA, kminB, kmaxB, nomask, (qq == 0), exB, r32, h, trA, m, l, negm, O);
        if (q + 1 < npair) NSA_LSTORE((q + 1) & 1);
        LDS_WAIT(); __syncthreads();
    }
    { const float lt = l + shx_(l, 32), inv = lt > 0.f ? g2 / lt : 0.f; nsa_fold<2>(park, mixrow, O, inv, h); }
}
__device__ __forceinline__ void ln_row(f32x4 (&a)[4], const float* g, const float* bta, int lane) {
    float s = 0.f;
#pragma unroll
    for (int j = 0; j < 4; ++j) s += (a[j].x + a[j].y) + (a[j].z + a[j].w);
    const float mean = wave_sum(s) * (1.0f / DM); float q = 0.f;
#pragma unroll
    for (int j = 0; j < 4; ++j) { a[j] = a[j] - mean; q += (a[j].x * a[j].x + a[j].y * a[j].y) + (a[j].z * a[j].z + a[j].w * a[j].w); }
    const float rstd = rsqrtf(wave_sum(q) * (1.0f / DM) + LN_EPS);
#pragma unroll
    for (int j = 0; j < 4; ++j) { const int col = (j >> 1) * 512 + 8 * lane + (j & 1) * 4; const f32x4 g4 = *(const f32x4*)(g + col), b4 = *(const f32x4*)(bta + col); a[j] = a[j] * rstd * g4 + b4; }
}
__device__ __forceinline__ void ph_ln1(const Params& p, const Ctx& c) {
    const int gw = c.vb * 8 + c.wave, NGW = c.nvb * 8; bf16_t* H1B = (bf16_t*)(p.ws + WS_H1B);
    for (int row = gw; row < NT; row += NGW) { float* xr = p.out + (size_t)row * DM; f32x4 a[4];
#pragma unroll
        for (int j = 0; j < 4; ++j) a[j] = *(const f32x4*)(xr + (j >> 1) * 512 + 8 * c.lane() + (j & 1) * 4);
        ln_row(a, p.ln1_g, p.ln1_b, c.lane());
#pragma unroll
        for (int j = 0; j < 4; ++j) *(f32x4*)(xr + (j >> 1) * 512 + 8 * c.lane() + (j & 1) * 4) = a[j];
#pragma unroll
        for (int j = 0; j < 2; ++j) { u32x4 o; o.x = pk2(a[2 * j].x, a[2 * j].y); o.y = pk2(a[2 * j].z, a[2 * j].w); o.z = pk2(a[2 * j + 1].x, a[2 * j + 1].y); o.w = pk2(a[2 * j + 1].z, a[2 * j + 1].w);
            *(u32x4*)(H1B + (size_t)row * DM + j * 512 + 8 * c.lane()) = o; } }
}
__device__ __forceinline__ void ph_route(const Params& p, const Ctx& c) {
    const int lane = c.lane(), grp = lane & 7, tk = lane >> 3;
    const float* LG = (const float*)(p.ws + WS_LOGITS); int* EIDX = (int*)(p.ws + WS_EIDX); float* WTS = (float*)(p.ws + WS_WTS); int* RANK = (int*)(p.ws + WS_RANK);
    unsigned* CNT = (unsigned*)(p.ws + WS_CTL) + CW_CNT;
    LAS unsigned* lcnt = (LAS unsigned*)c.lds; LAS unsigned* lbase = lcnt + NEXP;
    constexpr int TPB = 256;
    for (int blk = c.vb; blk < NT / TPB; blk += c.nvb) {
        __syncthreads();
        if (c.tid() < NEXP) lcnt[c.tid()] = 0u;
        __syncthreads();
        const int tb0 = blk * TPB, halfoff = 0;
        for (int it = 0; it < 4; ++it) { const int t = tb0 + c.wave * 32 + it * 8 + tk;
            float val[32];
#pragma unroll
            for (int q = 0; q < 8; ++q) { const f32x4 lg = *(const f32x4*)(LG + (size_t)t * NEXP + grp * 32 + 4 * q), rb = *(const f32x4*)(p.router_bias + grp * 32 + 4 * q);
#pragma unroll
                for (int i = 0; i < 4; ++i) val[4 * q + i] = 1.0f / (1.0f + __expf(-lg[i])) + rb[i]; }
            float a1 = fmaxf(val[0], val[1]), a2 = fminf(val[0], val[1]);
#pragma unroll
            for (int i = 2; i < 32; ++i) { const float v = val[i]; a2 = fmaxf(a2, fminf(a1, v)); a1 = fmaxf(a1, v); }
            const float gs = a1 + a2; int grank = 0;
#pragma unroll
            for (int k = 0; k < 8; ++k) { const float o = shi_(gs, (lane & ~7) + k); grank += (o > gs || (o == gs && k < grp)) ? 1 : 0; }
            if (grank >= 4) {
#pragma unroll
                for (int i = 0; i < 32; ++i) val[i] = -INFINITY; }
            int my_e = 0; float my_v = 0.f;
#pragma unroll 1
            for (int k = 0; k < TOPK; ++k) {
                float bv = val[0]; int bi = 0;
#pragma unroll
                for (int i = 1; i < 32; ++i) { const bool gt = val[i] > bv; bv = gt ? val[i] : bv; bi = gt ? i : bi; }
                bi += grp * 32;
#pragma unroll
                for (int o = 1; o < 8; o <<= 1) { const float ov = shx_(bv, o); const int oi = shx_(bi, o); const bool tk_ = (ov > bv) || (ov == bv && oi < bi); bv = tk_ ? ov : bv; bi = tk_ ? oi : bi; }
                const int li = (bi >> 5) == grp ? (bi & 31) : -1;
#pragma unroll
                for (int i = 0; i < 32; ++i) val[i] = (i == li) ? -INFINITY : val[i];
                if (grp == k) { my_e = bi; my_v = bv; }
            }
            const float sc = my_v - p.router_bias[my_e];
            float ssum = sc; ssum += shx_(ssum, 1); ssum += shx_(ssum, 2); ssum += shx_(ssum, 4);
            EIDX[(size_t)t * TOPK + grp] = my_e; WTS[(size_t)t * TOPK + grp] = sc / ssum * 2.5f;
            RANK[(size_t)t * TOPK + grp] = (int)__hip_atomic_fetch_add(lcnt + my_e, 1u, __ATOMIC_RELAXED, __HIP_MEMORY_SCOPE_WORKGROUP);
        }
        VM_WAIT(); LDS_WAIT(); __syncthreads();
        if (c.tid() < NEXP) { const unsigned n = lcnt[c.tid()]; lbase[c.tid()] = n ? __hip_atomic_fetch_add(CNT + halfoff + c.tid(), n, __ATOMIC_RELAXED, __HIP_MEMORY_SCOPE_AGENT) : 0u; }
        __syncthreads();
        for (int i = c.tid(); i < TPB * TOPK; i += 512) { const size_t gi = (size_t)tb0 * TOPK + i; RANK[gi] += (int)lbase[EIDX[gi]]; }
    }
}
constexpr int LDS_MISC = 131072;
constexpr int LM_BARW = LDS_MISC;
constexpr int LM_Q = LDS_MISC + 16;
constexpr int LM_OFFS = LDS_MISC + 64;
constexpr int LM_TB = LM_OFFS + 2064;
constexpr int LM_SCAN = LM_TB + 2064;
constexpr int LDS_BYTES = 147456;
static_assert(LM_SCAN + 4096 <= LDS_BYTES, "lds misc");
__device__ __forceinline__ void build_tables(const Params& p, const Ctx& c) {
    const unsigned* CNT = (const unsigned*)(p.ws + WS_CTL) + CW_CNT;
    LAS unsigned* offs = (LAS unsigned*)(c.lds + LM_OFFS); LAS unsigned* tb = (LAS unsigned*)(c.lds + LM_TB);
    LAS unsigned* s0 = (LAS unsigned*)(c.lds + LM_SCAN);
    const int t = c.tid(), lane = t & 63, w = t >> 6; const unsigned cn = t < NSEG ? __hip_atomic_load(CNT + t, __ATOMIC_RELAXED, __HIP_MEMORY_SCOPE_AGENT) : 0u;
    unsigned a = cn, b = (cn + 255u) >> 8;
#pragma unroll
    for (int o = 1; o < 64; o <<= 1) { const int src = lane >= o ? lane - o : lane; const unsigned ua = shi_(a, src), ub = shi_(b, src); if (lane >= o) { a += ua; b += ub; } }
    if (lane == 63) { s0[2 * w] = a; s0[2 * w + 1] = b; }
    __syncthreads();
    unsigned pa = 0, pb = 0;
#pragma unroll
    for (int k = 0; k < 8; ++k) { const unsigned xa = s0[2 * k], xb = s0[2 * k + 1]; if (k < w) { pa += xa; pb += xb; } }
    if (t < NSEG) { offs[t] = pa + a - cn; tb[t] = pb + b - ((cn + 255u) >> 8); }
    if (t == NSEG - 1) { offs[NSEG] = pa + a; tb[NSEG] = pb + b; }
    __syncthreads();
}
__device__ __forceinline__ void ph_scatter(const Params& p, const Ctx& c) {
    build_tables(p, c);
    const LAS unsigned* offs = (const LAS unsigned*)(c.lds + LM_OFFS);
    const int* EIDX = (const int*)(p.ws + WS_EIDX); const int* RANK = (const int*)(p.ws + WS_RANK); int* YROW = (int*)(p.ws + WS_YROW);
    const size_t gt = (size_t)c.vb * 512 + c.tid(), NGT = (size_t)c.nvb * 512;
    for (size_t i = gt; i < (size_t)NPAIR; i += NGT) { const int seg = EIDX[i]; YROW[offs[seg] + RANK[i]] = (int)i; }
    if (gt < 256) YROW[NPAIR + gt] = 0;
}
__device__ __forceinline__ int seg_of_tile(const LAS unsigned* tb, unsigned tile) { int lo = 0, hi = NSEG;
    while (hi - lo > 1) { const int mid = (lo + hi) >> 1; if ((unsigned)__builtin_amdgcn_readfirstlane((int)tb[mid]) <= tile) lo = mid; else hi = mid; } return lo; }
struct SchedMoE1 {
    const char* H1B; const char* WGU; const int* yrow; const LAS unsigned* offs; const LAS unsigned* tb; int G, c;
    __device__ __forceinline__ bool next(int i, pg8::Unit& u) const { const unsigned ntile = (unsigned)__builtin_amdgcn_readfirstlane((int)tb[NSEG]); const unsigned L = (unsigned)i * G + c; if (L >= 2 * ntile) return false; const unsigned tile = L >> 1; const int s = seg_of_tile(tb, tile); const unsigned row0 = offs[s] + 256u * (tile - tb[s]); const unsigned rem = offs[s + 1] - row0;
        u.pm = __builtin_amdgcn_readfirstlane((int)row0); u.pn = __builtin_amdgcn_readfirstlane((int)(L & 1)); u.a0 = __builtin_amdgcn_readfirstlane(rem < 256u ? (int)rem : 256); u.a1 = __builtin_amdgcn_readfirstlane(s & (NEXP - 1)); return true; }
    __device__ __forceinline__ const char* a_base(const pg8::Unit&) const { return H1B; }
    __device__ __forceinline__ unsigned a_off(const pg8::Unit& u, int row, int C) const { const int r = row < u.a0 ? row : u.a0 - 1; const unsigned tok = (unsigned)yrow[u.pm + r] >> 3; return (tok * DM + C) * 2u; }
    __device__ __forceinline__ size_t a_kstep() const { return 128; }
    __device__ __forceinline__ const char* b_base(const pg8::Unit& u) const { return WGU + ((size_t)u.a1 * 2 * DEXP + (size_t)u.pn * 256) * DM * 2; }
};
struct SchedMoE2 {
    const char* ACT; const char* WD; const LAS unsigned* offs; const LAS unsigned* tb; int G, c;
    __device__ __forceinline__ bool next(int i, pg8::Unit& u) const { const unsigned L = (unsigned)i * G + c; const unsigned ntile = (unsigned)__builtin_amdgcn_readfirstlane((int)tb[NSEG]); if (L >= 4 * ntile) return false;
        const unsigned tile = L >> 2; const int s = seg_of_tile(tb, tile); const unsigned row0 = offs[s] + 256u * (tile - tb[s]); const unsigned rem = offs[s + 1] - row0;
        u.pm = __builtin_amdgcn_readfirstlane((int)row0); u.pn = __builtin_amdgcn_readfirstlane((int)(L & 3)); u.a0 = __builtin_amdgcn_readfirstlane(rem < 256u ? (int)rem : 256); u.a1 = __builtin_amdgcn_readfirstlane(s & (NEXP - 1)); return true; }
    __device__ __forceinline__ const char* a_base(const pg8::Unit& u) const { return ACT + (size_t)u.pm * DEXP * 2; }
    __device__ __forceinline__ unsigned a_off(const pg8::Unit&, int row, int C) const { return (unsigned)(row * DEXP + C) * 2u; }
    __device__ __forceinline__ size_t a_kstep() const { return 128; }
    __device__ __forceinline__ const char* b_base(const pg8::Unit& u) const { return WD + ((size_t)u.a1 * DM + (size_t)u.pn * 256) * DEXP * 2; }
};
struct EpiAct {
    static constexpr bool PERM = true, AFTER_DRAIN = false;
    bf16_t* O; bool pos;
    __device__ __forceinline__ void operator()(const f32x4 (&acc)[2][2][4][2], const pg8::Unit& u, int wr, int wc, int fr, int fq) const {
        const size_t rbase = pos ? (size_t)u.pm : (size_t)u.pm * 256; const int nvalid = pos ? u.a0 : 256;
#pragma unroll
        for (int ai = 0; ai < 2; ++ai)
#pragma unroll
            for (int m = 0; m < 4; ++m) { const int r = ai * 128 + wr * 64 + m * 16 + fr;
                if (r < nvalid) {
#pragma unroll
                    for (int bj = 0; bj < 2; ++bj) { const int acol = (u.pn * 256 + bj * 128 + wc * 32 + 8 * fq) >> 1; const f32x4 v0 = acc[ai][bj][m][0], v1 = acc[ai][bj][m][1];
                        u32x2 o; o.x = pk2(siluf_(v0[0]) * v0[1], siluf_(v0[2]) * v0[3]); o.y = pk2(siluf_(v1[0]) * v1[1], siluf_(v1[2]) * v1[3]);
                        *(u32x2*)(O + (rbase + r) * DEXP + acol) = o; } } }
    }
};
struct EpiY {
    static constexpr bool PERM = true, AFTER_DRAIN = false;
    unsigned char* Y; const int* yrow;
    __device__ __forceinline__ void operator()(const f32x4 (&acc)[2][2][4][2], const pg8::Unit& u, int wr, int wc, int fr, int fq) const {
        int yr[2][4];
#pragma unroll
        for (int ai = 0; ai < 2; ++ai)
#pragma unroll
            for (int m = 0; m < 4; ++m) { const int r = ai * 128 + wr * 64 + m * 16 + fr; yr[ai][m] = yrow[u.pm + (r < u.a0 ? r : u.a0 - 1)]; }
#pragma unroll
        for (int ai = 0; ai < 2; ++ai)
#pragma unroll
            for (int m = 0; m < 4; ++m) { const int r = ai * 128 + wr * 64 + m * 16 + fr;
                if (r < u.a0) { const size_t y0 = (size_t)yr[ai][m];
#pragma unroll
                    for (int bj = 0; bj < 2; ++bj) { const int col0 = u.pn * 256 + bj * 128 + wc * 32 + 8 * fq; const f32x4 v0 = acc[ai][bj][m][0] * Y_SCALE, v1 = acc[ai][bj][m][1] * Y_SCALE;
                        int w0 = 0, w1 = 0;
                        w0 = __builtin_amdgcn_cvt_pk_fp8_f32(v0[0], v0[1], w0, false); w0 = __builtin_amdgcn_cvt_pk_fp8_f32(v0[2], v0[3], w0, true);
                        w1 = __builtin_amdgcn_cvt_pk_fp8_f32(v1[0], v1[1], w1, false); w1 = __builtin_amdgcn_cvt_pk_fp8_f32(v1[2], v1[3], w1, true);
                        u32x2 w; w.x = (unsigned)w0; w.y = (unsigned)w1;
                        *(u32x2*)(Y + y0 * DM + col0) = w; } } }
    }
};
__device__ __forceinline__ void ph_final(const Params& p, const Ctx& c) {
    const int gw = c.vb * 8 + c.wave, NGW = c.nvb * 8, lane = c.lane(); const unsigned char* Y = (const unsigned char*)(p.ws + WS_Y); const float* WTS = (const float*)(p.ws + WS_WTS);
    for (int t = gw; t < NT; t += NGW) { float* xr = p.out + (size_t)t * DM; f32x4 a[4];
#pragma unroll
        for (int j = 0; j < 4; ++j) a[j] = *(const f32x4*)(xr + (j >> 1) * 512 + 8 * lane + (j & 1) * 4);
        const f32x4 w0 = *(const f32x4*)(WTS + (size_t)t * TOPK), w1 = *(const f32x4*)(WTS + (size_t)t * TOPK + 4);
        const float wk[8] = {w0.x, w0.y, w0.z, w0.w, w1.x, w1.y, w1.z, w1.w};
        u32x2 yv[8][2];
#pragma unroll
        for (int k = 0; k < TOPK; ++k)
#pragma unroll
            for (int j = 0; j < 2; ++j) yv[k][j] = *(const u32x2*)(Y + ((size_t)t * TOPK + k) * DM + j * 512 + 8 * lane);
#pragma unroll
        for (int k = 0; k < TOPK; ++k) { const float wsc = wk[k] * (1.0f / Y_SCALE);
#pragma unroll
            for (int j = 0; j < 2; ++j) { const f32x2 e0 = __builtin_amdgcn_cvt_pk_f32_fp8((int)yv[k][j].x, false), e1 = __builtin_amdgcn_cvt_pk_f32_fp8((int)yv[k][j].x, true),
                                                   e2 = __builtin_amdgcn_cvt_pk_f32_fp8((int)yv[k][j].y, false), e3 = __builtin_amdgcn_cvt_pk_f32_fp8((int)yv[k][j].y, true);
                a[2 * j].x += wsc * e0.x; a[2 * j].y += wsc * e0.y; a[2 * j].z += wsc * e1.x; a[2 * j].w += wsc * e1.y;
                a[2 * j + 1].x += wsc * e2.x; a[2 * j + 1].y += wsc * e2.y; a[2 * j + 1].z += wsc * e3.x; a[2 * j + 1].w += wsc * e3.y; } }
        ln_row(a, p.ln2_g, p.ln2_b, lane);
#pragma unroll
        for (int j = 0; j < 4; ++j) *(f32x4*)(xr + (j >> 1) * 512 + 8 * lane + (j & 1) * 4) = a[j]; }
}
__device__ __forceinline__ void ph_inproj(const Params& p, const Ctx& c) {
    SchedPlain S{(const char*)(p.ws + WS_XB), (const char*)(p.ws + WS_WIN_T), DM, DM, NT / 256, NPROJ / 256, c.nvb, c.vb};
    EpiProj E{(bf16_t*)(p.ws + WS_PROJ), (const float*)(p.ws + WS_COS), (const float*)(p.ws + WS_SIN)};
    pg8::gemm_phase<EpiProj, SchedPlain, true>(c.lds, S, E, DM, c.wave);
}
__device__ __forceinline__ void ph_prep(const Params& p, const Ctx& c) {
    const int ncmp = c.nvb >= 128 ? 64 : 0;
    if (ncmp) {
        LAS float* lbias = (LAS float*)(c.lds + LM_SCAN);
        if (c.vb < 64) { const int t = c.tid(); if (t < 256) { const int which = c.vb & 1; float s = (which ? p.cmp_b1_v : p.cmp_b1_k)[t];
            for (int q = 0; q < 64; ++q) s += ((const float*)(p.ws + WS_BIASKV))[q * 512 + which * 256 + t]; lbias[t] = s; } }
        __syncthreads();
        SchedCmp S{(const char*)(p.ws + WS_PROJ), (const char*)(p.ws + WS_W1K_T), (const char*)(p.ws + WS_W1V_T), c.nvb, c.vb};
        EpiCmp E{lbias, (const bf16_t*)(p.ws + WS_W2K_T), (const bf16_t*)(p.ws + WS_W2V_T), (bf16_t*)(p.ws + WS_KC), (bf16_t*)(p.ws + WS_VC)};
        pg8::gemm_phase<EpiCmp, SchedCmp, false>(c.lds, S, E, 2048, c.wave);
        __syncthreads();
    }
    if (ncmp == 0) { for (int u = c.vb; u < NB * 32; u += c.nvb) gla_prep_unit(p, c, u); }
    else if (c.vb < ncmp) gla_prep_unit(p, c, c.vb);
    else for (int u = ncmp + (c.vb - ncmp); u < NB * 32; u += c.nvb - ncmp) gla_prep_unit(p, c, u);
}
constexpr int Q_GLA = NB * 4, Q_NSA = NB * 2 * 32, Q_CONV = 512;
#define QUEUE_LOOP(headword, total, BODY) for (;;) { __syncthreads(); if (c.tid() == 0) qb[0] = (int)__hip_atomic_fetch_add((headword), 1u, __ATOMIC_RELAXED, __HIP_MEMORY_SCOPE_AGENT); \
        __syncthreads(); const int idx = __builtin_amdgcn_readfirstlane(qb[0]); if (idx >= (total)) break; BODY; }
__device__ __forceinline__ void ph_mix(const Params& p, const Ctx& c) {
    unsigned* head = (unsigned*)(p.ws + WS_CTL) + CW_QHEAD;
    LAS int* qb = (LAS int*)(c.lds + LM_Q);
    QUEUE_LOOP(head, Q_GLA, gla_unit(p, c, idx));
    QUEUE_LOOP(head + 64, Q_NSA, nsa_unit(p, c, idx));
#if PROBE_ON == 2
}
__device__ __forceinline__ void ph_mix2(const Params& p, const Ctx& c) {
    unsigned* head = (unsigned*)(p.ws + WS_CTL) + CW_QHEAD;
    LAS int* qb = (LAS int*)(c.lds + LM_Q);
#endif
    QUEUE_LOOP(head + 128, Q_CONV, conv_wgu(p, c, idx * 128 + c.wave, 8, (idx + 1) * 128));
}
__device__ __forceinline__ void ph_outproj(const Params& p, const Ctx& c) {
    SchedPlain S{(const char*)(p.ws + WS_MIX), (const char*)(p.ws + WS_WO_T), DM, DM, NT / 256, DM / 256, c.nvb, c.vb};
    EpiAxpyF32 E{p.x, p.out, DM, DN_ALPHA};
    pg8::gemm_phase<EpiAxpyF32, SchedPlain, true>(c.lds, S, E, DM, c.wave);
}
__device__ __forceinline__ void ph_router(const Params& p, const Ctx& c) {
    SchedPlain S{(const char*)(p.ws + WS_H1B), (const char*)(p.ws + WS_WR_T), DM, DM, NT / 256, 1, c.nvb, c.vb};
    EpiAxpyF32 E{nullptr, (float*)(p.ws + WS_LOGITS), NEXP, 0.f};
    pg8::gemm_phase<EpiAxpyF32, SchedPlain, true>(c.lds, S, E, DM, c.wave);
}
__device__ __forceinline__ int xcd_vb(const Ctx& c) { return (c.nvb % 8 == 0) ? (c.vb % 8) * (c.nvb / 8) + c.vb / 8 : c.vb; }
__device__ __forceinline__ void ph_gemm1(const Params& p, const Ctx& c) {
    build_tables(p, c);
    { SchedMoE1 S{(const char*)(p.ws + WS_H1B), (const char*)(p.ws + WS_WGU_T), (const int*)(p.ws + WS_YROW), (const LAS unsigned*)(c.lds + LM_OFFS), (const LAS unsigned*)(c.lds + LM_TB), c.nvb, xcd_vb(c)};
      EpiAct E{(bf16_t*)(p.ws + WS_ACT), true};
      pg8::gemm_phase<EpiAct, SchedMoE1, true>(c.lds, S, E, DM, c.wave); }
    __syncthreads();
    { SchedPlain S{(const char*)(p.ws + WS_H1B), (const char*)(p.ws + WS_WSGU_T), DM, DM, NT / 256, 2, c.nvb, c.vb};
      EpiAct E{(bf16_t*)(p.ws + WS_ACTS), false};
      pg8::gemm_phase<EpiAct, SchedPlain, true>(c.lds, S, E, DM, c.wave); }
}
__device__ __forceinline__ void ph_gemm2(const Params& p, const Ctx& c) {
    build_tables(p, c);
    SchedMoE2 S{(const char*)(p.ws + WS_ACT), (const char*)(p.ws + WS_WD_T), (const LAS unsigned*)(c.lds + LM_OFFS), (const LAS unsigned*)(c.lds + LM_TB), c.nvb, xcd_vb(c)};
    EpiY E{(unsigned char*)(p.ws + WS_Y), (const int*)(p.ws + WS_YROW)};
    pg8::gemm_phase<EpiY, SchedMoE2, true>(c.lds, S, E, DEXP, c.wave);
}
__device__ __forceinline__ void ph_sh2(const Params& p, const Ctx& c) {
    SchedPlain S{(const char*)(p.ws + WS_ACTS), (const char*)(p.ws + WS_WSD_T), DEXP, DEXP, NT / 256, DM / 256, c.nvb, c.vb};
    EpiAxpyF32 E{p.out, p.out, DM, DN_ALPHA};
    pg8::gemm_phase<EpiAxpyF32, SchedPlain, true>(c.lds, S, E, DEXP, c.wave);
}
constexpr int N_PHASES = 12;
template <int PH> __device__ __forceinline__ void run_phase(const Params& p, const Ctx& c) {
    if constexpr (PH == 0) ph_prologue(p, c);
    if constexpr (PH == 1) ph_inproj(p, c);
    if constexpr (PH == 2) ph_prep(p, c);
    if constexpr (PH == 3) ph_mix(p, c);
    if constexpr (PH == 4) ph_outproj(p, c);
    if constexpr (PH == 5) { ph_ln1(p, c); conv_wd(p, c, c.vb * 8 + c.wave, c.nvb * 8, NEXP * 128); }
    if constexpr (PH == 6) ph_router(p, c);
    if constexpr (PH == 7) ph_route(p, c);
    if constexpr (PH == 8) ph_scatter(p, c);
    if constexpr (PH == 9) ph_gemm1(p, c);
    if constexpr (PH == 10) { ph_gemm2(p, c); __syncthreads(); ph_sh2(p, c); }
    if constexpr (PH == 11) ph_final(p, c);
}
#ifndef MK_MULTI
#define MK_MULTI 0
#endif
#if MK_MULTI
template <int PH> __global__ void __launch_bounds__(512, 2) k_phase(Params p) {
    extern __shared__ __attribute__((aligned(16))) unsigned char lds_raw[];
    Ctx c; c.lds = (LAS unsigned char*)lds_raw; c.wave = __builtin_amdgcn_readfirstlane((int)threadIdx.x >> 6);
    c.vb = blockIdx.x; c.nvb = gridDim.x;
    run_phase<PH>(p, c);
}
#endif
__global__ void __launch_bounds__(512, 2) k_mega(Params p) {
    extern __shared__ __attribute__((aligned(16))) unsigned char lds_raw[];
    Ctx c; c.lds = (LAS unsigned char*)lds_raw; c.wave = __builtin_amdgcn_readfirstlane((int)threadIdx.x >> 6);
    c.vb = blockIdx.x; c.nvb = gridDim.x;
    if (c.tid() < 4) ((LAS unsigned*)(c.lds + LM_BARW))[c.tid()] = 0u;
    __syncthreads();
    const XcdBarrier bar = xcd_barrier_post((unsigned*)(p.ws + WS_CTL) + CW_BAR, (volatile LAS unsigned*)(c.lds + LM_BARW), c.tid() == 0);
#if PROBE_ON
    unsigned long long ts_[N_PHASES + 1]; ts_[0] = __builtin_amdgcn_s_memrealtime();
#define STAMP(k) ts_[k] = __builtin_amdgcn_s_memrealtime()
#else
#define STAMP(k)
#endif
    run_phase<0>(p, c); xcd_barrier(bar, c.tid() == 0); STAMP(1);
    run_phase<1>(p, c); xcd_barrier(bar, c.tid() == 0); STAMP(2);
    run_phase<2>(p, c); xcd_barrier(bar, c.tid() == 0); STAMP(3);
    run_phase<3>(p, c); xcd_barrier(bar, c.tid() == 0); STAMP(4);
#if PROBE_ON == 2
    ph_mix2(p, c); xcd_barrier(bar, c.tid() == 0);
#endif
    run_phase<4>(p, c); xcd_barrier(bar, c.tid() == 0); STAMP(5);
    run_phase<5>(p, c); xcd_barrier(bar, c.tid() == 0); STAMP(6);
    run_phase<6>(p, c); xcd_barrier(bar, c.tid() == 0); STAMP(7);
    run_phase<7>(p, c); xcd_barrier(bar, c.tid() == 0); STAMP(8);
    run_phase<8>(p, c); xcd_barrier(bar, c.tid() == 0); STAMP(9);
    run_phase<9>(p, c); xcd_barrier(bar, c.tid() == 0); STAMP(10);
    run_phase<10>(p, c); xcd_barrier(bar, c.tid() == 0); STAMP(11);
    run_phase<11>(p, c); STAMP(12);
#if PROBE_ON
    if (blockIdx.x == 0) { __syncthreads();
        if (c.tid() == 0) { const unsigned long long tot = ts_[N_PHASES] - ts_[0], da = ts_[PROBE_A + 1] - ts_[PROBE_A], dt = ts_[PROBE_T + 1] - ts_[PROBE_T];
            const unsigned long long t0 = __builtin_amdgcn_s_memrealtime(); while (__builtin_amdgcn_s_memrealtime() - t0 < dt) __builtin_amdgcn_s_sleep(8);
            VM_WAIT(); p.out[0] += 1.0f + (float)((100ull * da) / (tot ? tot : 1ull)); } }
#endif
}
#ifndef MK_MULTI
#define MK_MULTI 0
#endif
#if MK_MULTI
template <int PH> static void launch_phase(const Params& p, int grid, hipStream_t stream) {
    static bool attr = false;
    if (!attr) { (void)hipFuncSetAttribute((const void*)k_phase<PH>, hipFuncAttributeMaxDynamicSharedMemorySize, LDS_BYTES); attr = true; }
    hipLaunchKernelGGL(k_phase<PH>, dim3(grid), dim3(512), LDS_BYTES, stream, p);
}
#endif
extern "C" void kernel_launch(void* const* d_in, const int* in_sizes, int n_in, void* d_out, int out_size, void* d_ws, size_t ws_size, hipStream_t stream) {
    if (n_in != 27 || ws_size < WS_END) { fprintf(stderr, "kernel_launch: unexpected inputs (n_in %d, ws %zu)\n", n_in, ws_size); return; }
    Params p{};
    p.x = (const float*)d_in[0]; p.positions = (const int*)d_in[1]; p.w_in = (const float*)d_in[2]; p.w_alpha2 = (const float*)d_in[3]; p.b_alpha = (const float*)d_in[4]; p.gla_norm_g = (const float*)d_in[5];
    p.cmp_pos_k = (const float*)d_in[6]; p.cmp_w1_k = (const float*)d_in[7]; p.cmp_b1_k = (const float*)d_in[8]; p.cmp_w2_k = (const float*)d_in[9];
    p.cmp_pos_v = (const float*)d_in[10]; p.cmp_w1_v = (const float*)d_in[11]; p.cmp_b1_v = (const float*)d_in[12]; p.cmp_w2_v = (const float*)d_in[13];
    p.w_out = (const float*)d_in[14]; p.ln1_g = (const float*)d_in[15]; p.ln1_b = (const float*)d_in[16]; p.w_router = (const float*)d_in[17]; p.router_bias = (const float*)d_in[18];
    p.w_exp_gate = (const float*)d_in[19]; p.w_exp_up = (const float*)d_in[20]; p.w_exp_down = (const float*)d_in[21]; p.w_sh_gate = (const float*)d_in[22]; p.w_sh_up = (const float*)d_in[23]; p.w_sh_down = (const float*)d_in[24];
    p.ln2_g = (const float*)d_in[25]; p.ln2_b = (const float*)d_in[26];
    p.out = (float*)d_out; p.ws = (unsigned char*)d_ws;
    (void)hipMemsetAsync((char*)d_ws + WS_CTL, 0, CTL_ZERO_BYTES, stream);
#if MK_MULTI
    const int grid = 256;
    launch_phase<0>(p, grid, stream); launch_phase<1>(p, grid, stream); launch_phase<2>(p, grid, stream); launch_phase<3>(p, grid, stream);
    launch_phase<4>(p, grid, stream); launch_phase<5>(p, grid, stream); launch_phase<6>(p, grid, stream); launch_phase<7>(p, grid, stream);
    launch_phase<8>(p, grid, stream); launch_phase<9>(p, grid, stream); launch_phase<10>(p, grid, stream); launch_phase<11>(p, grid, stream);
#else
    static int grid = 0;
    if (grid == 0) { int dev = 0, cus = 0;
        if (hipGetDevice(&dev) != hipSuccess || hipDeviceGetAttribute(&cus, hipDeviceAttributeMultiprocessorCount, dev) != hipSuccess || cus <= 0) cus = 256;
        (void)hipFuncSetAttribute((const void*)k_mega, hipFuncAttributeMaxDynamicSharedMemorySize, LDS_BYTES);
        grid = cus; }
    hipLaunchKernelGGL(k_mega, dim3(grid), dim3(512), LDS_BYTES, stream, p);
#endif
}
```
